# Optimizing an MI355X kernel written in HIP

```python
import jax, jax.numpy as jnp
from jax import lax
import numpy as np

D_MODEL = 2048
BATCH = 2
SEQ = 4096
DEPTH = 1

RET_HEADS = 4
RET_QK_DIM = 256
RET_V_DIM = 256
RET_WIDTH = RET_HEADS * RET_QK_DIM
RET_CHUNK = 128
ROPE_BASE = 10000.0
RWKV_HEAD = 64
RWKV_WIDTH = 1024
RWKV_HEADS = RWKV_WIDTH // RWKV_HEAD
DECAY_LORA = 96
ICLR_LORA = 96
GATE_LORA = 256
FFN_HIDDEN = ((8 * D_MODEL // 3 + 255) // 256) * 256
N_BRANCH = 2
RET_COLS = 4 * RET_WIDTH
SHIFT_COLS = 3 * RWKV_WIDTH + DECAY_LORA + ICLR_LORA + GATE_LORA
GATE_COLS = N_BRANCH * D_MODEL
IN_COLS = RET_COLS + SHIFT_COLS + GATE_COLS
NORM_EPS = 1e-6
GN_EPS_RET = 1e-5
GN_EPS_RWKV = 64e-5

kernel_name = "hybrid_retention_rwkv7_adaln_block"

F32 = jnp.float32


def rms_norm(x, gain):
    xf = x.astype(F32)
    y = xf * lax.rsqrt(jnp.mean(xf * xf, axis=-1, keepdims=True) + NORM_EPS)
    return (y * gain.astype(F32)).astype(x.dtype)


def head_group_norm(y, eps):
    mu = jnp.mean(y, axis=-1, keepdims=True)
    var = jnp.mean(jnp.square(y - mu), axis=-1, keepdims=True)
    return (y - mu) * lax.rsqrt(var + eps)


def rotary(t, pos):
    half = t.shape[-1] // 2
    inv_freq = ROPE_BASE ** (-jnp.arange(half, dtype=F32) / half)
    ang = pos.astype(F32)[..., None] * inv_freq
    cos = jnp.cos(ang)[:, :, None, :]
    sin = jnp.sin(ang)[:, :, None, :]
    t1, t2 = t[..., :half], t[..., half:]
    return jnp.concatenate([t1 * cos - t2 * sin, t1 * sin + t2 * cos], axis=-1)


def retention_chunkwise(q, k, v, pos):
    b, s, h, dk = q.shape
    dv = v.shape[-1]
    n = s // RET_CHUNK
    q = rotary(q, pos)
    k = rotary(k, pos) * (dk ** -0.5)

    def to_chunks(t):
        return t.reshape(b, n, RET_CHUNK, h, t.shape[-1]).transpose(0, 3, 1, 2, 4)

    qc, kc, vc = to_chunks(q), to_chunks(k), to_chunks(v)
    log_gamma = jnp.log(1.0 - 2.0 ** (-5.0 - jnp.arange(h, dtype=F32)))
    idx = jnp.arange(RET_CHUNK, dtype=F32)
    dist = idx[:, None] - idx[None, :]
    decay_intra = jnp.where(dist >= 0,
                            jnp.exp(log_gamma[:, None, None] * jnp.maximum(dist, 0.0)),
                            0.0)
    scores = jnp.einsum('bhncd,bhnsd->bhncs', qc, kc) * decay_intra[None, :, None]
    intra = jnp.einsum('bhncs,bhnsv->bhncv', scores, vc)

    zeta = jnp.exp(log_gamma[:, None] * (RET_CHUNK - 1.0 - idx))
    kv = jnp.einsum('bhncd,hc,bhncv->bhndv', kc, zeta, vc)
    chunk_decay = jnp.exp(log_gamma * RET_CHUNK)[None, :, None, None]

    def step(state, kv_n):
        return state * chunk_decay + kv_n, state

    _, states_before = lax.scan(step, jnp.zeros((b, h, dk, dv), F32), jnp.moveaxis(kv, 2, 0))
    states_before = jnp.moveaxis(states_before, 0, 2)
    xi = jnp.exp(log_gamma[:, None] * (idx + 1.0))
    cross = jnp.einsum('bhncd,bhndv->bhncv', qc, states_before) * xi[None, :, None, :, None]
    out = intra + cross
    return out.transpose(0, 2, 3, 1, 4).reshape(b, s, h, dv)


def rwkv7_recurrence(r, w, k, v, a_vec, b_vec):
    b, s, h, n = r.shape

    def step(state, inp):
        r_t, w_t, k_t, v_t, a_t, b_t = inp
        sa = jnp.einsum('bhvk,bhk->bhv', state, a_t)
        state = (state * w_t[:, :, None, :] + sa[..., None] * b_t[:, :, None, :]
                 + v_t[..., None] * k_t[:, :, None, :])
        return state, jnp.einsum('bhvk,bhk->bhv', state, r_t)

    xs = tuple(jnp.moveaxis(t, 1, 0) for t in (r, w, k, v, a_vec, b_vec))
    _, ys = lax.scan(step, jnp.zeros((b, h, n, n), F32), xs)
    return jnp.moveaxis(ys, 0, 1)


def hybrid_mixer(u, pos, w_in, b_gate, mu_shift, w0, w_decay_up, a0, w_iclr_up, w_gate_up,
                 k_k, k_a, r_k, lnx_w, lnx_b, w_ret_out, w_rwkv_out, w_o):
    bsz, s, _ = u.shape
    z = u @ w_in
    z_ret = z[..., :RET_COLS]
    z_rw = z[..., RET_COLS:RET_COLS + SHIFT_COLS]
    z_gate = z[..., RET_COLS + SHIFT_COLS:]

    q, k, v, g_ret = jnp.split(z_ret.astype(F32), 4, axis=-1)
    q = q.reshape(bsz, s, RET_HEADS, RET_QK_DIM)
    k = k.reshape(bsz, s, RET_HEADS, RET_QK_DIM)
    v = v.reshape(bsz, s, RET_HEADS, RET_V_DIM)
    y_ret = head_group_norm(retention_chunkwise(q, k, v, pos), GN_EPS_RET)
    y_ret = (jax.nn.silu(g_ret) * y_ret.reshape(bsz, s, RET_WIDTH)).astype(u.dtype)

    z_rw = z_rw.astype(F32)
    z_prev = jnp.pad(z_rw[:, :-1], ((0, 0), (1, 0), (0, 0)))
    z_rw = z_rw + (z_prev - z_rw) * mu_shift.astype(F32)
    o1, o2, o3 = RWKV_WIDTH, 2 * RWKV_WIDTH, 3 * RWKV_WIDTH
    o4, o5 = o3 + DECAY_LORA, o3 + DECAY_LORA + ICLR_LORA
    r, kw, vw = z_rw[..., :o1], z_rw[..., o1:o2], z_rw[..., o2:o3]
    zw, za, zg = z_rw[..., o3:o4], z_rw[..., o4:o5], z_rw[..., o5:]
    w_log = -jax.nn.softplus(-(w0.astype(F32) + jnp.tanh(zw) @ w_decay_up.astype(F32))) - 0.5
    decay = jnp.exp(-jnp.exp(w_log))
    iclr = jax.nn.sigmoid(a0.astype(F32) + za @ w_iclr_up.astype(F32))
    g_rw = jax.nn.sigmoid(zg) @ w_gate_up.astype(F32)

    heads = lambda t: t.reshape(bsz, s, RWKV_HEADS, RWKV_HEAD)
    r, kw, vw, decay, iclr = heads(r), heads(kw), heads(vw), heads(decay), heads(iclr)
    kk = kw * k_k.astype(F32).reshape(RWKV_HEADS, RWKV_HEAD)
    kk = kk / jnp.maximum(jnp.linalg.norm(kk, axis=-1, keepdims=True), 1e-12)
    k_mod = kw * (1.0 + (iclr - 1.0) * k_a.astype(F32).reshape(RWKV_HEADS, RWKV_HEAD))
    y_rw = rwkv7_recurrence(r, decay, k_mod, vw, -kk, kk * iclr)
    y_rw = (head_group_norm(y_rw, GN_EPS_RWKV) * lnx_w.astype(F32).reshape(RWKV_HEADS, RWKV_HEAD)
            + lnx_b.astype(F32).reshape(RWKV_HEADS, RWKV_HEAD))
    y_rw = y_rw + jnp.sum(r * k_mod * r_k.astype(F32), axis=-1, keepdims=True) * vw
    y_rw = (y_rw.reshape(bsz, s, RWKV_WIDTH) * g_rw).astype(u.dtype)

    gates = jax.nn.sigmoid(z_gate + b_gate)
    gate_ret, gate_rw = jnp.split(gates, N_BRANCH, axis=-1)
    merged = gate_ret * (y_ret @ w_ret_out) + gate_rw * (y_rw @ w_rwkv_out)
    return merged @ w_o


def swiglu(u, w_ffn_in, w_ffn_out):
    gate, up = jnp.split(u @ w_ffn_in, 2, axis=-1)
    return (jax.nn.silu(gate) * up) @ w_ffn_out


def setup_inputs(seed: int = 0) -> dict:
    key = jax.random.key(seed)
    ks = jax.random.split(key, 32)
    nrm = lambda k, shape, scale: jax.random.normal(k, shape, F32) * scale
    L, D = DEPTH, D_MODEL
    strides = jax.random.randint(ks[2], (BATCH, SEQ), 1, 3, dtype=jnp.int32)
    offset = jax.random.randint(ks[3], (BATCH, 1), 0, 1024, dtype=jnp.int32)
    positions = (offset + jnp.cumsum(strides, axis=1) - 1).astype(jnp.int32)
    w0 = (jnp.broadcast_to(jnp.linspace(-6.0, -1.0, RWKV_WIDTH, dtype=F32), (L, RWKV_WIDTH))
          + nrm(ks[9], (L, RWKV_WIDTH), 0.1))
    return {
        "x": nrm(ks[0], (BATCH, SEQ, D), 1.0),
        "c": nrm(ks[1], (BATCH, D), 1.0),
        "positions": positions,
        "w_ada": nrm(ks[4], (L, D, 6 * D), 0.5 * D ** -0.5),
        "b_ada": nrm(ks[5], (L, 6 * D), 0.01),
        "norm_mix": 1.0 + nrm(ks[6], (L, D), 0.02),
        "norm_ffn": 1.0 + nrm(ks[7], (L, D), 0.02),
        "norm_final": 1.0 + nrm(ks[8], (D,), 0.02),
        "w_in": nrm(ks[10], (L, D, IN_COLS), D ** -0.5),
        "b_gate": nrm(ks[11], (L, GATE_COLS), 0.1),
        "mu_shift": jax.random.uniform(ks[12], (L, SHIFT_COLS), F32),
        "w0": w0,
        "w_decay_up": nrm(ks[13], (L, DECAY_LORA, RWKV_WIDTH), 0.1),
        "a0": nrm(ks[14], (L, RWKV_WIDTH), 0.1),
        "w_iclr_up": nrm(ks[15], (L, ICLR_LORA, RWKV_WIDTH), 0.5 * ICLR_LORA ** -0.5),
        "w_gate_up": nrm(ks[16], (L, GATE_LORA, RWKV_WIDTH), GATE_LORA ** -0.5),
        "k_k": 0.85 + nrm(ks[17], (L, RWKV_WIDTH), 0.02),
        "k_a": 1.0 + nrm(ks[18], (L, RWKV_WIDTH), 0.02),
        "r_k": nrm(ks[19], (L, RWKV_HEADS, RWKV_HEAD), 0.1),
        "lnx_w": 1.0 + nrm(ks[20], (L, RWKV_WIDTH), 0.02),
        "lnx_b": nrm(ks[21], (L, RWKV_WIDTH), 0.01),
        "w_ret_out": nrm(ks[22], (L, RET_WIDTH, D), RET_WIDTH ** -0.5),
        "w_rwkv_out": nrm(ks[23], (L, RWKV_WIDTH, D), RWKV_WIDTH ** -0.5),
        "w_o": nrm(ks[24], (L, D, D), D ** -0.5),
        "w_ffn_in": nrm(ks[25], (L, D, 2 * FFN_HIDDEN), D ** -0.5),
        "w_ffn_out": nrm(ks[26], (L, FFN_HIDDEN, D), FFN_HIDDEN ** -0.5),
    }


def reference(x, c, positions, w_ada, b_ada, norm_mix, norm_ffn, norm_final, w_in, b_gate,
              mu_shift, w0, w_decay_up, a0, w_iclr_up, w_gate_up, k_k, k_a, r_k, lnx_w, lnx_b,
              w_ret_out, w_rwkv_out, w_o, w_ffn_in, w_ffn_out):
    h = x
    c_act = jax.nn.silu(c)
    for l in range(DEPTH):
        mod = c_act @ w_ada[l] + b_ada[l]
        sh1, sc1, g1, sh2, sc2, g2 = [m[:, None, :] for m in jnp.split(mod, 6, axis=-1)]
        u = rms_norm(h, norm_mix[l]) * (1.0 + sc1) + sh1
        h = h + g1 * hybrid_mixer(u, positions, w_in[l], b_gate[l], mu_shift[l], w0[l],
                                  w_decay_up[l], a0[l], w_iclr_up[l], w_gate_up[l], k_k[l],
                                  k_a[l], r_k[l], lnx_w[l], lnx_b[l], w_ret_out[l],
                                  w_rwkv_out[l], w_o[l])
        u = rms_norm(h, norm_ffn[l]) * (1.0 + sc2) + sh2
        h = h + g2 * swiglu(u, w_ffn_in[l], w_ffn_out[l])
    return rms_norm(h, norm_final)
```

```cpp
#include <hip/hip_runtime.h>
#include <cstdio>
#include <cstdint>

#define GAS __attribute__((address_space(1)))
#define LAS __attribute__((address_space(3)))
typedef unsigned short bf16_t;
typedef short bf16x8 __attribute__((ext_vector_type(8)));
typedef short s16x4 __attribute__((ext_vector_type(4)));
typedef float f32x4 __attribute__((ext_vector_type(4)));
typedef float f32x2 __attribute__((ext_vector_type(2)));
typedef unsigned u32x4 __attribute__((ext_vector_type(4)));
typedef unsigned u32x2 __attribute__((ext_vector_type(2)));
typedef __bf16 bf16x2_t __attribute__((ext_vector_type(2)));

constexpr int BATCH = 2, SEQ = 4096, M = BATCH * SEQ, D = 2048;
constexpr int ZC = 11776;
constexpr int ZO_Q = 0, ZO_K = 1024, ZO_V = 2048, ZO_G = 3072, ZO_RW = 4096, ZO_R = 4096, ZO_KW = 5120, ZO_VW = 6144, ZO_ZW = 7168, ZO_ZA = 7264, ZO_ZG = 7360, ZO_GATE = 7680;
constexpr int IN_COLS = 11712, FFH = 5632, FF2 = 2 * FFH;
constexpr int NWAVES = 8, NTHR = 512;
constexpr float NORM_EPS = 1e-6f;

constexpr size_t MiB = 1u << 20;
constexpr size_t WS_CTL = 0, CTL_ZERO_BYTES = 256 * 1024;
constexpr size_t WS_WIN = 1 * MiB;
constexpr size_t WS_U = 47 * MiB;
constexpr size_t WS_WMRG = 79 * MiB;
constexpr size_t WS_WO = 87 * MiB;
constexpr size_t WS_WF1 = 95 * MiB;
constexpr size_t WS_WF2 = 139 * MiB;
constexpr size_t WS_LORA = 161 * MiB;
constexpr size_t WS_ROPE = 162 * MiB;
constexpr size_t WS_Y = 170 * MiB;
constexpr size_t WS_Z = 202 * MiB;
constexpr size_t WS_END = 386 * MiB;
constexpr size_t WS_SF = WS_WIN;
constexpr int CW_TMO = 0, CW_CODE = 1, CW_ADA = 64, CW_Q0 = 128, CW_Q1 = 192, CW_Q2 = 256, CW_Q3 = 320, CW_BAR = 4096, CW_CNT = 8192, CW_MOD = 16384, CW_RSS1 = 49152, CW_RSS2 = 57344;

constexpr int RING_BYTES = 143360;
constexpr int LDSCTL_OFF = RING_BYTES, MISC_OFF = LDSCTL_OFF + 320;
constexpr int LDS_BYTES = 147456;

#define RLX_AGENT __ATOMIC_RELAXED, __HIP_MEMORY_SCOPE_AGENT
#define LDS_WAIT() asm volatile("s_waitcnt lgkmcnt(0)" ::: "memory")
#define VM_WAIT() asm volatile("s_waitcnt vmcnt(0)" ::: "memory")
__device__ __forceinline__ unsigned cvtpk(float lo, float hi) { f32x2 v = {lo, hi}; bf16x2_t b = __builtin_convertvector(v, bf16x2_t); return __builtin_bit_cast(unsigned, b); }
__device__ __forceinline__ float bflo(unsigned u) { return __uint_as_float(u << 16); }
__device__ __forceinline__ float bfhi(unsigned u) { return __uint_as_float(u & 0xffff0000u); }
__device__ __forceinline__ float bf2f(bf16_t b) { return __uint_as_float((unsigned)b << 16); }
__device__ __forceinline__ float sigmoidf_(float x) { return __builtin_amdgcn_rcpf(1.0f + __expf(-x)); }
__device__ __forceinline__ float siluf_(float x) { return x * __builtin_amdgcn_rcpf(1.0f + __expf(-x)); }
template <int CTRL> __device__ __forceinline__ float dppf(float v) { return __uint_as_float((unsigned)__builtin_amdgcn_update_dpp(0, (int)__float_as_uint(v), CTRL, 0xf, 0xf, true)); }
__device__ __forceinline__ float row_sum16(float v) {
    v += dppf<0xB1>(v); v += dppf<0x4E>(v); v += dppf<0x141>(v); v += dppf<0x140>(v); return v;
}
__device__ __forceinline__ float wave_sum(float v) {
    v = row_sum16(v);
    const unsigned u = __float_as_uint(v);
    return (__uint_as_float(__builtin_amdgcn_readlane(u, 0)) + __uint_as_float(__builtin_amdgcn_readlane(u, 16))) + (__uint_as_float(__builtin_amdgcn_readlane(u, 32)) + __uint_as_float(__builtin_amdgcn_readlane(u, 48)));
}
__device__ __forceinline__ s16x4 trread(const LAS unsigned char* p) {
    typedef short v4i16_t __attribute__((ext_vector_type(4)));
    return __builtin_bit_cast(s16x4, __builtin_amdgcn_ds_read_tr16_b64_v4i16((LAS v4i16_t*)p));
}
#define PK8(lo, hi) (bf16x8){lo[0], lo[1], lo[2], lo[3], hi[0], hi[1], hi[2], hi[3]}

#define XB_TMO      128
#define XB_XCNT(j)  (256  + 64 * (j))
#define XB_XSUB(j)  (1280 + 64 * (j))
#define XB_XGEN(j)  (2304 + 64 * (j))
#define XB_TOP      3328
#define XB_TOPGEN   3392
#define XCD_BAR_WORDS 3456
#define XB_SPIN_CAP (1u << 20)
__device__ __forceinline__ unsigned xb_ld(unsigned* p)              { return __hip_atomic_load(p, __ATOMIC_RELAXED, __HIP_MEMORY_SCOPE_AGENT); }
__device__ __forceinline__ unsigned xb_add(unsigned* p, unsigned v) { return __hip_atomic_fetch_add(p, v, __ATOMIC_RELAXED, __HIP_MEMORY_SCOPE_AGENT); }
__device__ __forceinline__ unsigned xb_xcc_id() { return (unsigned)__builtin_amdgcn_s_getreg((3 << 11) | 20) & 0xFu; }
#define XB_SPIN(cond, bar) do { unsigned _sp = 0; while (cond) { __builtin_amdgcn_s_sleep(1); \
    if ((++_sp & 255u) == 0u) { if (xb_ld(&(bar)[XB_TMO])) break; if (_sp > XB_SPIN_CAP) { atomicAdd(&(bar)[XB_TMO], 1u); break; } } } } while (0)
struct XcdBarrier { unsigned* bar; unsigned x; volatile LAS unsigned* st; };
__device__ __forceinline__ XcdBarrier xcd_barrier_post(unsigned* bar, volatile LAS unsigned* st) {
    XcdBarrier b; b.bar = bar; b.x = xb_xcc_id(); b.st = st;
    if (threadIdx.x == 0) (void)xb_add(&bar[XB_XCNT(b.x)], 1u);
    return b;
}
__device__ __forceinline__ void xcd_barrier_complete(unsigned* bar, unsigned x, unsigned& nloc, unsigned& nx) {
    const unsigned G = gridDim.x * gridDim.y * gridDim.z;
    unsigned sum, cnt, mine, sp = 0u;
    for (;;) {
        sum = 0u; cnt = 0u; mine = 0u;
#pragma unroll
        for (unsigned j = 0; j < 16; ++j) { const unsigned c = xb_ld(&bar[XB_XCNT(j)]); sum += c; cnt += (c > 0u) ? 1u : 0u; mine = (j == x) ? c : mine; }
        if (sum == G) break;
        __builtin_amdgcn_s_sleep(1);
        if ((++sp & 255u) == 0u) { if (xb_ld(&bar[XB_TMO])) break; if (sp > XB_SPIN_CAP) { atomicAdd(&bar[XB_TMO], 1u); break; } }
    }
    nloc = mine > 0u ? mine : 1u; nx = cnt > 0u ? cnt : 1u;
}
__device__ __forceinline__ void xcd_barrier(const XcdBarrier& b) {
    asm volatile("s_waitcnt vmcnt(0)" ::: "memory");
    __syncthreads();
    if (threadIdx.x == 0) {
        unsigned* bar = b.bar;
        __builtin_amdgcn_s_waitcnt(0);
        unsigned nloc = b.st[0], nx = b.st[1];
        if (nloc == 0u) { xcd_barrier_complete(bar, b.x, nloc, nx); b.st[0] = nloc; b.st[1] = nx; }
        const unsigned old = xb_add(&bar[XB_XSUB(b.x)], 1u);
        const unsigned gen = old / nloc;
        if (old + 1u == (gen + 1u) * nloc) {
            __builtin_amdgcn_fence(__ATOMIC_RELEASE, "agent");
            asm volatile("s_waitcnt vmcnt(0)" ::: "memory");
            const unsigned og = xb_add(&bar[XB_TOP], 1u);
            const unsigned tg = og / nx;
            if (og + 1u == (tg + 1u) * nx) xb_add(&bar[XB_TOPGEN], 1u);
            else XB_SPIN(xb_ld(&bar[XB_TOPGEN]) == tg, bar);
            __builtin_amdgcn_fence(__ATOMIC_ACQUIRE, "agent");
            xb_add(&bar[XB_XGEN(b.x)], 1u);
            asm volatile("s_waitcnt vmcnt(0)" ::: "memory");
        } else {
            XB_SPIN(xb_ld(&bar[XB_XGEN(b.x)]) == gen, bar);
            __builtin_amdgcn_fence(__ATOMIC_ACQUIRE, "agent");
            asm volatile("s_waitcnt vmcnt(0)" ::: "memory");
        }
    }
    __syncthreads();
}

namespace pg8 {
constexpr int BM = 256, BK = 64, HALF = 128, HTB = HALF * BK * 2, STAGE_BYTES = 8 * HTB, NXCD = 8, WGM = 8;
__host__ __device__ __forceinline__ int lds_byte(int r, int c) { const int st = (r >> 4) * 2 + (c >> 5), rr = r & 15, cc = c & 31, ob = rr * 64 + cc * 2; return st * 1024 + (ob ^ (((ob >> 9) & 1) << 5)); }
__host__ __device__ __forceinline__ void stage_rc(int b, int& R, int& C) { const int st = b / 1024, sb = b % 1024, swz = sb ^ (((sb >> 9) & 1) << 5); R = (st >> 1) * 16 + swz / 64; C = (st & 1) * 32 + (swz % 64) / 2; }
__host__ __device__ __forceinline__ int perm32(int rho) { const int n = rho >> 4, i = rho & 15; return 8 * (i >> 2) + 4 * n + (i & 3); }
struct Unit { int pm, pn; };
struct Gemm { const bf16_t* A; const bf16_t* Bt; int M, N, K, lda, ldb, tmid; };
struct StaticOrder {
    int nM, nN, nwg, G, c;
    __device__ void init(int M_, int N_, int G_, int c_) { nM = M_ / BM; nN = N_ / BM; nwg = nM * nN; G = G_; c = c_; }
    __device__ bool next(int i, Unit& u) const {
        const long L = (long)i * G + c; if (L >= nwg) return false;
        int wgid = (int)L; { const int q = nwg / NXCD, r = nwg % NXCD, xcd = wgid % NXCD, off = wgid / NXCD; wgid = (xcd < r ? xcd * (q + 1) : r * (q + 1) + (xcd - r) * q) + off; }
        const int nig = WGM * nN, gid = wgid / nig, fm = gid * WGM, gsz = (nM - fm) < WGM ? (nM - fm) : WGM;
        u.pm = fm + ((wgid % nig) % gsz); u.pn = (wgid % nig) / gsz; return true;
    }
};
template <class Epi, bool ALIGN_EPI, bool SP2>
__device__ __forceinline__ void gemm_phase(LAS unsigned char* lds, const Gemm g, const StaticOrder& S, const Epi& E) {
    const int tid = threadIdx.x, wid = __builtin_amdgcn_readfirstlane(tid >> 6), lane = tid & 63, wr = wid >> 2, wc = wid & 3, fr = lane & 15, fq = lane >> 4;
    const int K = g.K, nt = K / BK;
    unsigned voffA[2], voffB[2];
#pragma unroll
    for (int i = 0; i < 2; ++i) { int R, C; stage_rc(tid * 16 + i * 8192, R, C); const int Rb = Epi::PERM ? ((R & ~31) + perm32(R & 31)) : R;
        voffA[i] = (unsigned)(R * g.lda + C) * 2u; voffB[i] = (unsigned)(Rb * g.ldb + C) * 2u; }
    const size_t kstep = (size_t)(BK * 2);
    const size_t hstepA = (size_t)HALF * g.lda * 2, hstepB = (size_t)HALF * g.ldb * 2;
    const size_t tstepA = 2 * hstepA, tstepB = 2 * hstepB;
    const unsigned ldsw = (unsigned)wid * 1024u;
    const int aoff = lds_byte(wr * 64 + fr, fq * 8), boff = lds_byte(wc * 32 + fr, fq * 8);
#define PG8_SA(b, h) (((b) * 2 + (h)) * HTB)
#define PG8_SB(b, h) ((4 + (b) * 2 + (h)) * HTB)
#define PG8_STAGE(bufoff, gbase, voff) do { _Pragma("unroll") for (int _i = 0; _i < 2; ++_i) \
        __builtin_amdgcn_global_load_lds((const unsigned*)((const char*)(gbase) + (voff)[_i]), (LAS unsigned*)(lds + (bufoff) + ldsw + _i * 8192), 16, 0, 0); } while (0)
#define PG8_LDA(dst, b, h) do { _Pragma("unroll") for (int m = 0; m < 4; ++m) _Pragma("unroll") for (int k = 0; k < 2; ++k) dst[m][k] = *(const LAS bf16x8*)(lds + PG8_SA(b, h) + aoff + m * 2048 + k * 1024); } while (0)
#define PG8_LDB(dst, b, h) do { _Pragma("unroll") for (int n = 0; n < 2; ++n) _Pragma("unroll") for (int k = 0; k < 2; ++k) dst[n][k] = *(const LAS bf16x8*)(lds + PG8_SB(b, h) + boff + n * 2048 + k * 1024); } while (0)
#define PG8_MMA(ai, bj, At, Bt) do { __builtin_amdgcn_s_setprio(1); _Pragma("unroll") for (int m = 0; m < 4; ++m) _Pragma("unroll") for (int n = 0; n < 2; ++n) _Pragma("unroll") for (int k = 0; k < 2; ++k) \
        acc[ai][bj][m][n] = __builtin_amdgcn_mfma_f32_16x16x32_bf16(Bt[n][k], At[m][k], acc[ai][bj][m][n], 0, 0, 0); __builtin_amdgcn_s_setprio(0); } while (0)
#define PG8_WAIT_V(n) asm volatile("s_waitcnt vmcnt(" #n ")" ::: "memory")
#define PG8_WAIT_L(n) asm volatile("s_waitcnt lgkmcnt(" #n ")" ::: "memory")
#define PG8_BAR __builtin_amdgcn_s_barrier()
#define PG8_SCHED __builtin_amdgcn_sched_barrier(0)
    Unit cur, nxt; int ui = 0;
    if (!S.next(0, cur)) return;
    f32x4 acc[2][2][4][2];
#pragma unroll
    for (int a = 0; a < 2; ++a)
#pragma unroll
        for (int b = 0; b < 2; ++b)
#pragma unroll
            for (int m = 0; m < 4; ++m)
#pragma unroll
                for (int n = 0; n < 2; ++n) acc[a][b][m][n] = (f32x4){0.f, 0.f, 0.f, 0.f};
    bf16x8 At[4][2], B0[2][2], B1[2][2];
    const char* cA = (const char*)g.A + (size_t)cur.pm * tstepA; const char* cB = (const char*)g.Bt + (size_t)cur.pn * tstepB;
    if constexpr (SP2) {
        PG8_STAGE(PG8_SB(0, 0), cB, voffB); PG8_STAGE(PG8_SB(0, 1), cB + hstepB, voffB); PG8_STAGE(PG8_SA(0, 0), cA, voffA); PG8_STAGE(PG8_SA(0, 1), cA + hstepA, voffA);
        if (wr == 1) PG8_BAR;
        PG8_WAIT_V(2); PG8_BAR;
        PG8_STAGE(PG8_SB(1, 0), cB + kstep, voffB); PG8_STAGE(PG8_SA(1, 0), cA + kstep, voffA); PG8_STAGE(PG8_SB(1, 1), cB + hstepB + kstep, voffB);
        PG8_WAIT_V(6); PG8_BAR;
    } else {
        PG8_STAGE(PG8_SB(0, 0), cB, voffB); PG8_STAGE(PG8_SA(0, 0), cA, voffA); PG8_STAGE(PG8_SB(0, 1), cB + hstepB, voffB); PG8_STAGE(PG8_SA(0, 1), cA + hstepA, voffA);
        if (wr == 1) PG8_BAR;
        PG8_WAIT_V(4); PG8_BAR;
        PG8_STAGE(PG8_SB(1, 0), cB + kstep, voffB); PG8_STAGE(PG8_SA(1, 0), cA + kstep, voffA); PG8_STAGE(PG8_SB(1, 1), cB + hstepB + kstep, voffB);
        PG8_WAIT_V(6); PG8_BAR;
    }
    for (;;) {
        const bool has_next = S.next(ui + 1, nxt);
        const char* nA = has_next ? (const char*)g.A + (size_t)nxt.pm * tstepA : cA; const char* nB = has_next ? (const char*)g.Bt + (size_t)nxt.pn * tstepB : cB;
        for (int t = 0; t < nt; t += 2) {
            if constexpr (Epi::HAS_MID) { if (t == g.tmid) E.mid(acc, cur, wr, wc, fr, fq); }
            const bool last = (t == nt - 2);
            const char* a1 = cA + (size_t)(t + 1) * kstep;
            const char* a2 = last ? nA : cA + (size_t)(t + 2) * kstep; const char* b2 = last ? nB : cB + (size_t)(t + 2) * kstep;
            const char* a3 = a2 + kstep; const char* b3 = b2 + kstep;
            if constexpr (SP2) {
            PG8_LDB(B0, 0, 0); PG8_LDB(B1, 0, 1); PG8_SCHED; PG8_LDA(At, 0, 0); PG8_STAGE(PG8_SA(1, 1), a1 + hstepA, voffA);
            PG8_WAIT_V(8); PG8_WAIT_L(0); PG8_BAR; PG8_MMA(0, 0, At, B0); PG8_MMA(0, 1, At, B1); PG8_BAR; PG8_SCHED;
            PG8_LDA(At, 0, 1); PG8_STAGE(PG8_SB(0, 0), b2, voffB); PG8_STAGE(PG8_SB(0, 1), b2 + hstepB, voffB); PG8_STAGE(PG8_SA(0, 0), a2, voffA);
            PG8_WAIT_V(8); PG8_WAIT_L(0); PG8_BAR; PG8_MMA(1, 0, At, B0); PG8_MMA(1, 1, At, B1); PG8_BAR; PG8_SCHED;
            PG8_LDB(B0, 1, 0); PG8_LDB(B1, 1, 1); PG8_SCHED; PG8_LDA(At, 1, 0); PG8_STAGE(PG8_SA(0, 1), a2 + hstepA, voffA);
            PG8_WAIT_V(8); PG8_WAIT_L(0); PG8_BAR; PG8_MMA(0, 0, At, B0); PG8_MMA(0, 1, At, B1); PG8_BAR; PG8_SCHED;
            PG8_LDA(At, 1, 1); PG8_STAGE(PG8_SB(1, 0), b3, voffB); PG8_STAGE(PG8_SB(1, 1), b3 + hstepB, voffB); PG8_STAGE(PG8_SA(1, 0), a3, voffA);
            PG8_WAIT_V(8); PG8_WAIT_L(0); PG8_BAR; PG8_MMA(1, 0, At, B0); PG8_MMA(1, 1, At, B1); PG8_BAR; PG8_SCHED;
            } else {
            PG8_LDB(B0, 0, 0); PG8_SCHED; PG8_LDA(At, 0, 0); PG8_STAGE(PG8_SA(1, 1), a1 + hstepA, voffA);
            PG8_WAIT_L(8); PG8_BAR; PG8_WAIT_L(0); PG8_MMA(0, 0, At, B0); PG8_BAR; PG8_SCHED;
            PG8_LDB(B1, 0, 1); PG8_STAGE(PG8_SB(0, 0), b2, voffB);
            PG8_BAR; PG8_WAIT_L(0); PG8_MMA(0, 1, At, B1); PG8_BAR;
            PG8_LDA(At, 0, 1); PG8_STAGE(PG8_SA(0, 0), a2, voffA);
            PG8_BAR; PG8_WAIT_L(0); PG8_MMA(1, 0, At, B0); PG8_BAR; PG8_SCHED;
            PG8_STAGE(PG8_SB(0, 1), b2 + hstepB, voffB);
            PG8_WAIT_V(6); PG8_BAR; PG8_MMA(1, 1, At, B1); PG8_BAR;
            PG8_LDB(B0, 1, 0); PG8_SCHED; PG8_LDA(At, 1, 0); PG8_STAGE(PG8_SA(0, 1), a2 + hstepA, voffA);
            PG8_WAIT_L(8); PG8_BAR; PG8_WAIT_L(0); PG8_MMA(0, 0, At, B0); PG8_BAR; PG8_SCHED;
            PG8_LDB(B1, 1, 1); PG8_STAGE(PG8_SB(1, 0), b3, voffB);
            PG8_BAR; PG8_WAIT_L(0); PG8_MMA(0, 1, At, B1); PG8_BAR;
            PG8_LDA(At, 1, 1); PG8_STAGE(PG8_SA(1, 0), a3, voffA);
            PG8_BAR; PG8_WAIT_L(0); PG8_MMA(1, 0, At, B0); PG8_BAR; PG8_SCHED;
            PG8_STAGE(PG8_SB(1, 1), b3 + hstepB, voffB);
            PG8_WAIT_V(6); PG8_BAR; PG8_MMA(1, 1, At, B1); PG8_BAR;
            }
        }
        if constexpr (ALIGN_EPI) { if (wr == 0) PG8_BAR; }
        if constexpr (!Epi::AFTER_DRAIN) E(acc, cur, wr, wc, fr, fq);
        if (!has_next) break;
#pragma unroll
        for (int a = 0; a < 2; ++a)
#pragma unroll
            for (int b = 0; b < 2; ++b)
#pragma unroll
                for (int m = 0; m < 4; ++m)
#pragma unroll
                    for (int n = 0; n < 2; ++n) acc[a][b][m][n] = (f32x4){0.f, 0.f, 0.f, 0.f};
        cur = nxt; cA = nA; cB = nB; ++ui;
        if constexpr (ALIGN_EPI) { if (wr == 1) PG8_BAR; }
    }
    PG8_WAIT_V(0);
    if constexpr (!ALIGN_EPI) { if (wr == 0) PG8_BAR; }
    PG8_BAR;
    if constexpr (Epi::AFTER_DRAIN) E.fused(acc, cur, wr, wc, fr, fq, wid, lane, lds);
#undef PG8_SA
#undef PG8_SB
#undef PG8_STAGE
#undef PG8_LDA
#undef PG8_LDB
#undef PG8_MMA
#undef PG8_WAIT_V
#undef PG8_WAIT_L
#undef PG8_BAR
#undef PG8_SCHED
}

struct EpiZ {
    static constexpr bool PERM = true; static constexpr bool HAS_MID = false, AFTER_DRAIN = false;
    bf16_t* Z; const float* rc; const float* rs; const float* bg;
    __device__ __forceinline__ void operator()(f32x4 (&acc)[2][2][4][2], const Unit& u, int wr, int wc, int fr, int fq) const {
        const int row0 = u.pm * BM + wr * 64 + fr, col0 = u.pn * BM + wc * 32 + 8 * fq;
        const bool rot = u.pn < 8; const float sc = (u.pn >= 4 && u.pn < 8) ? 0.0625f : 1.0f;
        const bool isg = u.pn >= ZO_GATE / 256;
        f32x4 bg00, bg01, bg10, bg11;
        if (isg) { const float* bp = bg + (col0 - ZO_GATE); bg00 = *(const f32x4*)bp; bg01 = *(const f32x4*)(bp + 4); bg10 = *(const f32x4*)(bp + HALF); bg11 = *(const f32x4*)(bp + HALF + 4); }
#pragma unroll
        for (int ai = 0; ai < 2; ++ai)
#pragma unroll
            for (int m = 0; m < 4; ++m) {
                const int row = row0 + ai * HALF + m * 16;
                f32x4 v00 = acc[ai][0][m][0], v01 = acc[ai][0][m][1], v10 = acc[ai][1][m][0], v11 = acc[ai][1][m][1];
                if (rot) {
                    const float* pc = rc + (size_t)row * 128 + wc * 32 + 8 * fq; const float* ps = rs + (size_t)row * 128 + wc * 32 + 8 * fq;
                    const f32x4 c0 = *(const f32x4*)pc, c1 = *(const f32x4*)(pc + 4), s0 = *(const f32x4*)ps, s1 = *(const f32x4*)(ps + 4);
                    const f32x4 a0 = v00 * c0 - v10 * s0, b0 = v00 * s0 + v10 * c0, a1 = v01 * c1 - v11 * s1, b1 = v01 * s1 + v11 * c1;
                    v00 = a0 * sc; v10 = b0 * sc; v01 = a1 * sc; v11 = b1 * sc;
                }
                if (isg) {
#pragma unroll
                    for (int i = 0; i < 4; ++i) { v00[i] = sigmoidf_(v00[i] + bg00[i]); v01[i] = sigmoidf_(v01[i] + bg01[i]); v10[i] = sigmoidf_(v10[i] + bg10[i]); v11[i] = sigmoidf_(v11[i] + bg11[i]); }
                }
                bf16_t* rowp = Z + (size_t)row * ZC + col0;
                u32x4 w0, w1; w0.x = cvtpk(v00[0], v00[1]); w0.y = cvtpk(v00[2], v00[3]); w0.z = cvtpk(v01[0], v01[1]); w0.w = cvtpk(v01[2], v01[3]);
                w1.x = cvtpk(v10[0], v10[1]); w1.y = cvtpk(v10[2], v10[3]); w1.z = cvtpk(v11[0], v11[1]); w1.w = cvtpk(v11[2], v11[3]);
                __builtin_nontemporal_store(w0, (u32x4*)rowp); __builtin_nontemporal_store(w1, (u32x4*)(rowp + HALF));
            }
    }
};
#define LD4F(basep, boff) (*(const f32x4*)((const char*)(basep) + (unsigned)(boff)))
#define LD2U(basep, boff) (*(const u32x2*)((const char*)(basep) + (unsigned)(boff)))
struct EpiMerge {
    static constexpr bool PERM = true, HAS_MID = true, AFTER_DRAIN = false;
    const bf16_t* Z; bf16_t* O;
    __device__ __forceinline__ void mid(f32x4 (&acc)[2][2][4][2], const Unit& u, int wr, int wc, int fr, int fq) const {
        const int row0 = u.pm * BM + wr * 64 + fr, col0 = u.pn * BM + wc * 32 + 8 * fq;
        unsigned zo = ((unsigned)row0 * ZC + ZO_GATE + col0) * 2u; asm volatile("" : "+v"(zo));
#pragma unroll
        for (int ai = 0; ai < 2; ++ai) {
#pragma unroll
            for (int m = 0; m < 4; ++m)
#pragma unroll
                for (int bj = 0; bj < 2; ++bj) {
                    const unsigned zoff = zo + (unsigned)((ai * HALF + m * 16) * ZC + bj * HALF) * 2u;
                    const u32x4 za = *(const u32x4*)((const char*)Z + zoff), zb = *(const u32x4*)((const char*)Z + zoff + 4096u);
                    f32x4 r0, r1;
                    r0[0] = bflo(za.x) * __builtin_amdgcn_rcpf(bflo(zb.x)); r0[1] = bfhi(za.x) * __builtin_amdgcn_rcpf(bfhi(zb.x)); r0[2] = bflo(za.y) * __builtin_amdgcn_rcpf(bflo(zb.y)); r0[3] = bfhi(za.y) * __builtin_amdgcn_rcpf(bfhi(zb.y));
                    r1[0] = bflo(za.z) * __builtin_amdgcn_rcpf(bflo(zb.z)); r1[1] = bfhi(za.z) * __builtin_amdgcn_rcpf(bfhi(zb.z)); r1[2] = bflo(za.w) * __builtin_amdgcn_rcpf(bflo(zb.w)); r1[3] = bfhi(za.w) * __builtin_amdgcn_rcpf(bfhi(zb.w));
                    acc[ai][bj][m][0] *= r0; acc[ai][bj][m][1] *= r1;
                }
            asm volatile("" ::: "memory");
        }
    }
    __device__ __forceinline__ void operator()(f32x4 (&acc)[2][2][4][2], const Unit& u, int wr, int wc, int fr, int fq) const {
        const int row0 = u.pm * BM + wr * 64 + fr, col0 = u.pn * BM + wc * 32 + 8 * fq;
        unsigned zo = ((unsigned)row0 * ZC + ZO_GATE + 2048 + col0) * 2u, oo = ((unsigned)row0 * 2048 + col0) * 2u; asm volatile("" : "+v"(zo), "+v"(oo));
#pragma unroll
        for (int ai = 0; ai < 2; ++ai) {
#pragma unroll
            for (int m = 0; m < 4; ++m)
#pragma unroll
                for (int bj = 0; bj < 2; ++bj) {
                    const int rb = ai * HALF + m * 16;
                    const u32x4 zb = *(const u32x4*)((const char*)Z + (zo + (unsigned)(rb * ZC + bj * HALF) * 2u));
                    const f32x4 a0 = acc[ai][bj][m][0], a1 = acc[ai][bj][m][1];
                    u32x4 w; w.x = cvtpk(a0[0] * bflo(zb.x), a0[1] * bfhi(zb.x)); w.y = cvtpk(a0[2] * bflo(zb.y), a0[3] * bfhi(zb.y)); w.z = cvtpk(a1[0] * bflo(zb.z), a1[1] * bfhi(zb.z)); w.w = cvtpk(a1[2] * bflo(zb.w), a1[3] * bfhi(zb.w));
                    *(u32x4*)((char*)O + (oo + (unsigned)(rb * 2048 + bj * HALF) * 2u)) = w;
                }
            asm volatile("" ::: "memory");
        }
    }
};
template <int MODE> struct EpiResNorm {
    static constexpr bool PERM = false, HAS_MID = false, AFTER_DRAIN = true;
    const float* base; float* hout; const float* gate; const float* gain; const float* scsh; bf16_t* uout; float* rss; unsigned* cnt;
    __device__ __forceinline__ void fused(f32x4 (&acc)[2][2][4][2], const Unit& u, int wr, int wc, int fr, int fq, int wid, int lane, LAS unsigned char* lds) const {
        const int row0 = u.pm * BM + wr * 64 + fr, col0 = u.pn * BM + wc * 32 + 4 * fq;
        const int bat = (u.pm * BM) / SEQ;
        const float* gb = gate + (size_t)bat * 12288;
        const unsigned o0 = ((unsigned)row0 * 2048 + col0) * 4u;
        f32x4 g4[2][2];
#pragma unroll
        for (int bj = 0; bj < 2; ++bj)
#pragma unroll
            for (int n = 0; n < 2; ++n) g4[bj][n] = LD4F(gb, (col0 + bj * HALF + n * 16) * 4);
#pragma unroll
        for (int ai = 0; ai < 2; ++ai)
#pragma unroll
            for (int m = 0; m < 4; ++m) {
#pragma unroll
                for (int bj = 0; bj < 2; ++bj)
#pragma unroll
                    for (int n = 0; n < 2; ++n) {
                        const unsigned off = o0 + (unsigned)((ai * HALF + m * 16) * 2048 + bj * HALF + n * 16) * 4u;
                        const f32x4 v = LD4F(base, off) + g4[bj][n] * acc[ai][bj][m][n];
                        acc[ai][bj][m][n] = v;
                        if (MODE == 0) *(f32x4*)((char*)hout + off) = v;
                    }
                asm volatile("" : "+v"(acc[ai][0][m][0]), "+v"(acc[ai][0][m][1]), "+v"(acc[ai][1][m][0]), "+v"(acc[ai][1][m][1]));
                if (m == 3) asm volatile("" ::: "memory");
            }
        LAS float* P = (LAS float*)lds;
        LAS float* S = (LAS float*)(lds + 4096);
#pragma unroll
        for (int ai = 0; ai < 2; ++ai)
#pragma unroll
            for (int m = 0; m < 4; ++m) {
                float ss = 0.f;
#pragma unroll
                for (int bj = 0; bj < 2; ++bj)
#pragma unroll
                    for (int n = 0; n < 2; ++n) { const f32x4 v = acc[ai][bj][m][n]; ss += (v[0] * v[0] + v[1] * v[1]) + (v[2] * v[2] + v[3] * v[3]); }
                ss += __shfl_xor(ss, 16); ss += __shfl_xor(ss, 32);
                if (fq == 0) P[(ai * HALF + wr * 64 + m * 16 + fr) * 4 + wc] = ss;
            }
        asm volatile("s_waitcnt lgkmcnt(0)" ::: "memory"); __syncthreads();
        const int tid = threadIdx.x;
        float* slot = rss + (size_t)u.pm * BM + tid;
        if (tid < 256) {
            const f32x4 p4 = *(const LAS f32x4*)(P + tid * 4);
            __hip_atomic_store(slot + (size_t)u.pn * 8192, (p4[0] + p4[1]) + (p4[2] + p4[3]), __ATOMIC_RELAXED, __HIP_MEMORY_SCOPE_AGENT);
        }
        asm volatile("s_waitcnt vmcnt(0)" ::: "memory");
        __syncthreads();
        unsigned* c = cnt + 64 * u.pm;
        if (tid == 0) {
            __hip_atomic_fetch_add(c, 1u, __ATOMIC_RELAXED, __HIP_MEMORY_SCOPE_AGENT);
            unsigned sp = 0;
            while (__hip_atomic_load(c, __ATOMIC_RELAXED, __HIP_MEMORY_SCOPE_AGENT) < 8u) { __builtin_amdgcn_s_sleep(2); if (++sp > (1u << 22)) break; }
            __builtin_amdgcn_fence(__ATOMIC_ACQUIRE, "agent");
            asm volatile("s_waitcnt vmcnt(0)" ::: "memory");
        }
        __syncthreads();
        if (tid < 256) {
            float tot = 0.f;
#pragma unroll
            for (int t = 0; t < 8; ++t) tot += __hip_atomic_load(slot + (size_t)t * 8192, __ATOMIC_RELAXED, __HIP_MEMORY_SCOPE_AGENT);
            S[tid] = rsqrtf(tot * (1.0f / 2048.0f) + NORM_EPS);
        }
        asm volatile("s_waitcnt lgkmcnt(0)" ::: "memory"); __syncthreads();
        const float* mb = scsh + (size_t)bat * 12288;
        unsigned u0 = ((unsigned)row0 * 2048 + col0) * 2u, o1 = o0; asm volatile("" : "+v"(u0), "+v"(o1));
#pragma unroll
        for (int ai = 0; ai < 2; ++ai)
#pragma unroll
            for (int m = 0; m < 4; ++m) {
                const int rb = ai * HALF + m * 16;
                const float rstd = S[rb + wr * 64 + fr];
#pragma unroll
                for (int bj = 0; bj < 2; ++bj)
#pragma unroll
                    for (int n = 0; n < 2; ++n) {
                        const int cb = bj * HALF + n * 16;
                        const f32x4 gn = LD4F(gain, (col0 + cb) * 4);
                        f32x4 o = acc[ai][bj][m][n] * rstd * gn;
                        if (MODE == 0) {
                            const f32x4 sc = LD4F(mb, (2048 + col0 + cb) * 4), sh = LD4F(mb, (col0 + cb) * 4);
                            o = o * (sc + 1.0f) + sh;
                            u32x2 w; w.x = cvtpk(o[0], o[1]); w.y = cvtpk(o[2], o[3]);
                            *(u32x2*)((char*)uout + (u0 + (unsigned)(rb * 2048 + cb) * 2u)) = w;
                        } else *(f32x4*)((char*)hout + (o1 + (unsigned)(rb * 2048 + cb) * 4u)) = o;
                    }
                asm volatile("" ::: "memory");
            }
    }
};
struct EpiNull {
    static constexpr bool PERM = false, HAS_MID = false, AFTER_DRAIN = false;
    __device__ __forceinline__ void operator()(f32x4 (&acc)[2][2][4][2], const Unit& u, int wr, int wc, int fr, int fq) const {
#pragma unroll
        for (int ai = 0; ai < 2; ++ai)
#pragma unroll
            for (int m = 0; m < 4; ++m) asm volatile("" :: "v"(acc[ai][0][m][0]), "v"(acc[ai][0][m][1]), "v"(acc[ai][1][m][0]), "v"(acc[ai][1][m][1]));
    }
};
template <int LDC, int COFF> struct EpiPlain {
    static constexpr bool PERM = true, HAS_MID = false, AFTER_DRAIN = false;
    bf16_t* O;
    __device__ __forceinline__ void operator()(f32x4 (&acc)[2][2][4][2], const Unit& u, int wr, int wc, int fr, int fq) const {
        const int row0 = u.pm * BM + wr * 64 + fr, col0 = COFF + u.pn * BM + wc * 32 + 8 * fq;
        const unsigned o0 = ((unsigned)row0 * LDC + col0) * 2u;
#pragma unroll
        for (int ai = 0; ai < 2; ++ai)
#pragma unroll
            for (int m = 0; m < 4; ++m)
#pragma unroll
                for (int bj = 0; bj < 2; ++bj) {
                    const f32x4 v0 = acc[ai][bj][m][0], v1 = acc[ai][bj][m][1];
                    u32x4 w; w.x = cvtpk(v0[0], v0[1]); w.y = cvtpk(v0[2], v0[3]); w.z = cvtpk(v1[0], v1[1]); w.w = cvtpk(v1[2], v1[3]);
                    *(u32x4*)((char*)O + (o0 + (unsigned)((ai * HALF + m * 16) * LDC + bj * HALF) * 2u)) = w;
                }
    }
};
struct EpiSwiglu {
    static constexpr bool PERM = true; static constexpr bool HAS_MID = false, AFTER_DRAIN = false;
    bf16_t* H;
    __device__ __forceinline__ void operator()(f32x4 (&acc)[2][2][4][2], const Unit& u, int wr, int wc, int fr, int fq) const {
        const int row0 = u.pm * BM + wr * 64 + fr, col0 = u.pn * HALF + wc * 32 + 8 * fq;
#pragma unroll
        for (int ai = 0; ai < 2; ++ai)
#pragma unroll
            for (int m = 0; m < 4; ++m) {
                const f32x4 g0 = acc[ai][0][m][0], g1 = acc[ai][0][m][1], u0 = acc[ai][1][m][0], u1 = acc[ai][1][m][1];
                f32x4 h0, h1;
#pragma unroll
                for (int i = 0; i < 4; ++i) { h0[i] = siluf_(g0[i]) * u0[i]; h1[i] = siluf_(g1[i]) * u1[i]; }
                u32x4 w; w.x = cvtpk(h0[0], h0[1]); w.y = cvtpk(h0[2], h0[3]); w.z = cvtpk(h1[0], h1[1]); w.w = cvtpk(h1[2], h1[3]);
                __builtin_nontemporal_store(w, (u32x4*)(H + (size_t)(row0 + ai * HALF + m * 16) * FFH + col0));
            }
    }
};
}

struct Frame {
    LAS unsigned char* lds; volatile LAS unsigned* MISC; unsigned* ctl;
    int tid, lane, wave, vcu, G;
    const float* const* in; float* out; unsigned char* ws;
};
#define IN_F(k) ((const float*)F.in[k])

__device__ __forceinline__ void p0_ada(Frame& F, float wscale) {
    const float* c = IN_F(1); const float* w = IN_F(3); const float* bA = IN_F(4);
    float* mod = (float*)(F.ctl + CW_MOD);
    for (int item = F.vcu; item < 48 * 4; item += F.G) {
        const int cg = item % 48, ksg = item / 48, ks = ksg * 8 + F.wave, col = cg * 256 + F.lane * 4;
        const float s0 = siluf_(c[ks * 64 + F.lane]), s1 = siluf_(c[2048 + ks * 64 + F.lane]);
        f32x4 a0 = {0.f, 0.f, 0.f, 0.f}, a1 = {0.f, 0.f, 0.f, 0.f};
        const float* wp = w + (size_t)(ks * 64) * 12288 + col;
#pragma unroll 16
        for (int kk = 0; kk < 64; ++kk) {
            const f32x4 wv = __builtin_nontemporal_load((const f32x4*)(wp + (size_t)kk * 12288));
            const float c0 = __uint_as_float(__builtin_amdgcn_readlane(__float_as_uint(s0), kk)), c1 = __uint_as_float(__builtin_amdgcn_readlane(__float_as_uint(s1), kk));
            a0 += wv * c0; a1 += wv * c1;
        }
        LAS float* red = (LAS float*)F.lds;
#pragma unroll
        for (int i = 0; i < 4; ++i) { red[(F.wave * 8 + i) * 64 + F.lane] = a0[i]; red[(F.wave * 8 + 4 + i) * 64 + F.lane] = a1[i]; }
        __syncthreads();
        {
            float sum = 0.f;
#pragma unroll
            for (int ww = 0; ww < 8; ++ww) sum += red[(ww * 8 + F.wave) * 64 + F.lane];
            const int i = F.wave & 3, bt = F.wave >> 2, cc = cg * 256 + F.lane * 4 + i;
            if (ksg == 0) sum += bA[cc];
            atomicAdd(mod + bt * 12288 + cc, sum * wscale);
        }
        asm volatile("s_waitcnt vmcnt(0)" ::: "memory");
        __syncthreads();
        if (F.tid == 0) __hip_atomic_fetch_add(F.ctl + CW_ADA, 1u, __ATOMIC_RELAXED, __HIP_MEMORY_SCOPE_AGENT);
    }
}
__device__ __forceinline__ void p0_wait_ada(Frame& F, unsigned want) {
    unsigned sp = 0;
    while (__hip_atomic_load(F.ctl + CW_ADA, __ATOMIC_RELAXED, __HIP_MEMORY_SCOPE_AGENT) < want) { __builtin_amdgcn_s_sleep(4); if (++sp > (1u << 22)) break; }
    __builtin_amdgcn_fence(__ATOMIC_ACQUIRE, "agent");
    asm volatile("s_waitcnt vmcnt(0)" ::: "memory");
}
constexpr int TI0 = 32 * 183, TI1 = 16 * 32, TI2 = 16 * 32, TI3 = 32 * 32, TI4 = 32 * 176, TI5 = 88 * 32;
constexpr int TR_WIN_LO = 0, TR_WIN_HI = TI0, TR_MO_LO = TI0, TR_MO_HI = TI0 + TI1 + TI2 + TI3, TR_F1_LO = TR_MO_HI, TR_F1_HI = TR_MO_HI + TI4, TR_F2_LO = TR_F1_HI, TR_F2_HI = TR_F1_HI + TI5;
struct TrItem { const float* src; int Ns, k0, n0; bf16_t* dst; int dpitch, drow, dk0; };
__device__ __forceinline__ TrItem tr_decode(Frame& F, int it) {
    TrItem t; int r = it;
    if (r < TI0) { const int kb = r / 183, nb = r % 183, n0 = nb * 64; t = TrItem{IN_F(8), IN_COLS, kb * 64, n0, (bf16_t*)(F.ws + WS_WIN), 2048, n0 < 7616 ? n0 : n0 + 64, kb * 64}; return t; } r -= TI0;
    if (r < TI1) { const int kb = r / 32, nb = r % 32; t = TrItem{IN_F(21), 2048, kb * 64, nb * 64, (bf16_t*)(F.ws + WS_WMRG), 2048, nb * 64, kb * 64}; return t; } r -= TI1;
    if (r < TI2) { const int kb = r / 32, nb = r % 32; t = TrItem{IN_F(22), 2048, kb * 64, nb * 64, (bf16_t*)(F.ws + WS_WMRG), 2048, nb * 64, 1024 + kb * 64}; return t; } r -= TI2;
    if (r < TI3) { const int kb = r / 32, nb = r % 32; t = TrItem{IN_F(23), 2048, kb * 64, nb * 64, (bf16_t*)(F.ws + WS_WO), 2048, nb * 64, kb * 64}; return t; } r -= TI3;
    if (r < TI4) { const int kb = r / 176, nb = r % 176, n0 = nb * 64, half = n0 / FFH, jj = n0 % FFH;
        t = TrItem{IN_F(24), FF2, kb * 64, n0, (bf16_t*)(F.ws + WS_WF1), 2048, (jj / 128) * 256 + half * 128 + (jj % 128), kb * 64}; return t; } r -= TI4;
    { const int kb = r / 32, nb = r % 32; t = TrItem{IN_F(25), 2048, kb * 64, nb * 64, (bf16_t*)(F.ws + WS_WF2), FFH, nb * 64, kb * 64}; return t; }
}
__device__ __forceinline__ void tr_load(const TrItem& t, f32x4 (&v)[16], int lane) {
#pragma unroll
    for (int i = 0; i < 16; ++i) v[i] = __builtin_nontemporal_load((const f32x4*)(t.src + (size_t)(t.k0 + 4 * i + (lane >> 4)) * t.Ns + t.n0 + (lane & 15) * 4));
}
__device__ __forceinline__ void tr_finish(const TrItem& t, const f32x4 (&v)[16], LAS float* scr, int lane) {
#pragma unroll
    for (int i = 0; i < 16; ++i) { LAS float* sp = scr + (4 * i + (lane >> 4)) * 65 + (lane & 15) * 4; sp[0] = v[i][0]; sp[1] = v[i][1]; sp[2] = v[i][2]; sp[3] = v[i][3]; }
    LDS_WAIT(); asm volatile("" ::: "memory");
    const int c = lane >> 3;
#pragma unroll
    for (int j = 0; j < 8; ++j) {
        const int n = (lane & 7) + 8 * j; const LAS float* sp = scr + (8 * c) * 65 + n;
        u32x4 o; o.x = cvtpk(sp[0], sp[65]); o.y = cvtpk(sp[2 * 65], sp[3 * 65]); o.z = cvtpk(sp[4 * 65], sp[5 * 65]); o.w = cvtpk(sp[6 * 65], sp[7 * 65]);
        *(u32x4*)(t.dst + (size_t)(t.drow + n) * t.dpitch + t.dk0 + 8 * c) = o;
    }
    LDS_WAIT(); asm volatile("" ::: "memory");
}
__device__ __forceinline__ void p0_transposes(Frame& F, int lo, int n, int gw, int NGW) {
    LAS float* scr = (LAS float*)(F.lds + F.wave * 16896);
    f32x4 va[16], vb[16];
    int ia = gw;
    if (ia >= n) return;
    TrItem ta = tr_decode(F, lo + ia), tb = ta;
    tr_load(ta, va, F.lane);
    for (;;) {
        const int ib = ia + NGW;
        if (ib < n) { tb = tr_decode(F, lo + ib); tr_load(tb, vb, F.lane); }
        tr_finish(ta, va, scr, F.lane);
        if (ib >= n) break;
        ia = ib + NGW;
        if (ia < n) { ta = tr_decode(F, lo + ia); tr_load(ta, va, F.lane); }
        tr_finish(tb, vb, scr, F.lane);
        if (ia >= n) break;
    }
}
__device__ __forceinline__ void p0_small(Frame& F, int v0) {
    const int gt = (F.vcu - v0) * NTHR + F.tid, NT = (F.G - v0) * NTHR;
    bf16_t* lt = (bf16_t*)(F.ws + WS_LORA);
    for (int it = gt; it < 12288 + 12288 + 32768; it += NT) {
        const float* src; int kc, col, KK; bf16_t* dst;
        if (it < 12288) { src = IN_F(12); kc = it >> 10; col = it & 1023; KK = 96; dst = lt; }
        else if (it < 24576) { src = IN_F(14); kc = (it - 12288) >> 10; col = it & 1023; KK = 96; dst = lt + 1024 * 96; }
        else { src = IN_F(15); kc = (it - 24576) >> 10; col = it & 1023; KK = 256; dst = lt + 2 * 1024 * 96; }
        float v[8];
#pragma unroll
        for (int e = 0; e < 8; ++e) v[e] = src[(size_t)(kc * 8 + e) * 1024 + col];
        u32x4 o; o.x = cvtpk(v[0], v[1]); o.y = cvtpk(v[2], v[3]); o.z = cvtpk(v[4], v[5]); o.w = cvtpk(v[6], v[7]);
        *(u32x4*)(dst + (size_t)col * KK + kc * 8) = o;
    }
    for (int it = gt; it < 16384; it += NT) ((u32x4*)((bf16_t*)(F.ws + WS_WIN) + (size_t)7616 * 2048))[it] = (u32x4){0u, 0u, 0u, 0u};
    const int* pos = (const int*)F.in[2];
    float* rc = (float*)(F.ws + WS_ROPE); float* rs = rc + (size_t)M * 128;
    for (int idx = gt; idx < M * 128; idx += NT) {
        const int tok = idx >> 7, j = idx & 127;
        const double y = -(double)j * (9.210340371976184 / 128.0);
        const double nn = __builtin_rint(y * 1.4426950408889634), r = __builtin_fma(-nn, 6.93147180369123816490e-01, y) - nn * 1.90821492927058770002e-10;
        double e = 1.0 / 87178291200.0;
        e = e * r + 1.0 / 6227020800.0; e = e * r + 1.0 / 479001600.0; e = e * r + 1.0 / 39916800.0; e = e * r + 1.0 / 3628800.0; e = e * r + 1.0 / 362880.0; e = e * r + 1.0 / 40320.0;
        e = e * r + 1.0 / 5040.0; e = e * r + 1.0 / 720.0; e = e * r + 1.0 / 120.0; e = e * r + 1.0 / 24.0; e = e * r + 1.0 / 6.0; e = e * r + 0.5; e = e * r + 1.0; e = e * r + 1.0;
        const long long sh = (long long)nn; const double sc = __builtin_bit_cast(double, (unsigned long long)(1023 + sh) << 52);
        const float inv = (float)(e * sc);
        const float ang = (float)pos[tok] * inv;
        const double a = (double)ang;
        const double qn = __builtin_rint(a * 6.36619772367581382433e-01);
        double t = __builtin_fma(-qn, 1.57079632673412561417e+00, a); t = __builtin_fma(-qn, 6.07710050650619224932e-11, t);
        const double z = t * t;
        const double sn = t + t * z * (-1.66666666666666324348e-01 + z * (8.33333333332248946124e-03 + z * (-1.98412698298579493134e-04 + z * (2.75573137070700676789e-06 + z * (-2.50507602534068634195e-08 + z * 1.58969099521155010221e-10)))));
        const double cs = 1.0 - 0.5 * z + z * z * (4.16666666666666019037e-02 + z * (-1.38888888888741095749e-03 + z * (2.48015872894767294178e-05 + z * (-2.75573143513906633035e-07 + z * (2.08757232129817482790e-09 + z * -1.13596475577881948265e-11)))));
        const int qd = (int)((long long)qn & 3);
        const double so = (qd == 0) ? sn : (qd == 1) ? cs : (qd == 2) ? -sn : -cs;
        const double co = (qd == 0) ? cs : (qd == 1) ? -sn : (qd == 2) ? -cs : sn;
        rc[idx] = (float)co; rs[idx] = (float)so;
    }
}
__device__ __forceinline__ void norm_mod_rows(Frame& F, const float* src, const float* gain, int sc_off, int sh_off, bf16_t* dst) {
    const float* mod = (const float*)(F.ctl + CW_MOD);
    const int gw = F.vcu * NWAVES + F.wave, NGW = F.G * NWAVES;
    f32x4 v[8], nx[8], cg[8], ch[8];
    if (gw < M) {
#pragma unroll
        for (int j = 0; j < 8; ++j) nx[j] = __builtin_nontemporal_load((const f32x4*)(src + (size_t)gw * D) + F.lane + 64 * j);
    }
    int cur_b = -1;
    for (int row = gw; row < M; row += NGW) {
        float ss = 0.f;
#pragma unroll
        for (int j = 0; j < 8; ++j) { v[j] = nx[j]; ss += (v[j][0] * v[j][0] + v[j][1] * v[j][1]) + (v[j][2] * v[j][2] + v[j][3] * v[j][3]); }
        if (row + NGW < M) {
#pragma unroll
            for (int j = 0; j < 8; ++j) nx[j] = __builtin_nontemporal_load((const f32x4*)(src + (size_t)(row + NGW) * D) + F.lane + 64 * j);
        }
        const int bt = row / SEQ;
        if (bt != cur_b) {
            cur_b = bt; const float* mb = mod + (size_t)bt * 12288;
#pragma unroll
            for (int j = 0; j < 8; ++j) { const int col = 256 * j + 4 * F.lane; cg[j] = *(const f32x4*)(gain + col) * (*(const f32x4*)(mb + sc_off + col) + 1.0f); ch[j] = *(const f32x4*)(mb + sh_off + col); }
        }
        const float rstd = rsqrtf(wave_sum(ss) * (1.0f / D) + NORM_EPS);
#pragma unroll
        for (int j = 0; j < 8; ++j) {
            const f32x4 o = v[j] * rstd * cg[j] + ch[j];
            u32x2 w; w.x = cvtpk(o[0], o[1]); w.y = cvtpk(o[2], o[3]);
            *(u32x2*)(dst + (size_t)row * D + 256 * j + 4 * F.lane) = w;
        }
    }
}
__device__ __forceinline__ void final_norm_rows(Frame& F, float* io, const float* gain) {
    const int gw = F.vcu * NWAVES + F.wave, NGW = F.G * NWAVES;
    for (int row = gw; row < M; row += NGW) {
        f32x4* xr = (f32x4*)(io + (size_t)row * D) + F.lane;
        f32x4 v[8]; float ss = 0.f;
#pragma unroll
        for (int j = 0; j < 8; ++j) { v[j] = xr[64 * j]; ss += (v[j][0] * v[j][0] + v[j][1] * v[j][1]) + (v[j][2] * v[j][2] + v[j][3] * v[j][3]); }
        const float rstd = rsqrtf(wave_sum(ss) * (1.0f / D) + NORM_EPS);
#pragma unroll
        for (int j = 0; j < 8; ++j) { const f32x4 gn = *(const f32x4*)(gain + 256 * j + 4 * F.lane); xr[64 * j] = v[j] * rstd * gn; }
    }
}

constexpr int RK_PITCH = 528, RV_PITCH = 544;
__device__ __forceinline__ float ret_lg2(int h) { return log2f(1.0f - exp2f(-5.0f - (float)h)); }
__device__ __forceinline__ u32x4 scale8(u32x4 v, float s) {
    u32x4 o; o.x = cvtpk(bflo(v.x) * s, bfhi(v.x) * s); o.y = cvtpk(bflo(v.y) * s, bfhi(v.y) * s); o.z = cvtpk(bflo(v.z) * s, bfhi(v.z) * s); o.w = cvtpk(bflo(v.w) * s, bfhi(v.w) * s); return o;
}
__device__ __forceinline__ void ret_kv_unit(Frame& F, int unit) {
    const int n = unit & 31, bh = unit >> 5, h = bh & 3, b = bh >> 2;
    const bf16_t* Z = (const bf16_t*)(F.ws + WS_Z);
    const size_t row0 = (size_t)b * SEQ + (size_t)n * 128;
    const float lg2 = ret_lg2(h);
    LAS unsigned char* Kt = F.lds; LAS unsigned char* Vt = F.lds + 64 * RV_PITCH;
    const int w = F.wave, lane = F.lane, li = lane & 15, g = lane >> 4, q = li >> 2, p = li & 3;
    f32x4 acc[2][16];
#pragma unroll
    for (int a = 0; a < 2; ++a)
#pragma unroll
        for (int d = 0; d < 16; ++d) acc[a][d] = (f32x4){0.f, 0.f, 0.f, 0.f};
    for (int hh = 0; hh < 2; ++hh) {
#pragma unroll
        for (int i = 0; i < 4; ++i) {
            const int e = F.tid + NTHR * i, row = e >> 5, ch = e & 31;
            const bf16_t* zr = Z + (row0 + 64 * hh + row) * ZC + 256 * h + 8 * ch;
            const u32x4 kv = *(const u32x4*)(zr + ZO_K), vv = *(const u32x4*)(zr + ZO_V);
            const float zeta = exp2f((float)(127 - (64 * hh + row)) * lg2);
            *(LAS u32x4*)(Kt + row * RV_PITCH + ch * 16) = scale8(kv, zeta);
            *(LAS u32x4*)(Vt + row * RV_PITCH + ch * 16) = vv;
        }
        __syncthreads();
#pragma unroll
        for (int ks = 0; ks < 2; ++ks) {
            const LAS unsigned char* ka = Kt + (32 * ks + 8 * g + q) * RV_PITCH + (32 * w + 4 * p) * 2;
            const s16x4 a0l = trread(ka), a0h = trread(ka + 4 * RV_PITCH), a1l = trread(ka + 32), a1h = trread(ka + 32 + 4 * RV_PITCH);
            const bf16x8 a0 = PK8(a0l, a0h), a1 = PK8(a1l, a1h);
            const LAS unsigned char* vb = Vt + (32 * ks + 8 * g + q) * RV_PITCH + (4 * p) * 2;
#pragma unroll
            for (int d = 0; d < 16; ++d) {
                const s16x4 bl = trread(vb + d * 32), bhh = trread(vb + d * 32 + 4 * RV_PITCH);
                const bf16x8 bb = PK8(bl, bhh);
                acc[0][d] = __builtin_amdgcn_mfma_f32_16x16x32_bf16(a0, bb, acc[0][d], 0, 0, 0);
                acc[1][d] = __builtin_amdgcn_mfma_f32_16x16x32_bf16(a1, bb, acc[1][d], 0, 0, 0);
            }
        }
        __syncthreads();
    }
    bf16_t* SF = (bf16_t*)(F.ws + WS_SF) + (size_t)unit * 65536;
#pragma unroll
    for (int d = 0; d < 16; ++d) {
        u32x4 o; o.x = cvtpk(acc[0][d][0], acc[0][d][1]); o.y = cvtpk(acc[0][d][2], acc[0][d][3]); o.z = cvtpk(acc[1][d][0], acc[1][d][1]); o.w = cvtpk(acc[1][d][2], acc[1][d][3]);
        *(u32x4*)(SF + ((size_t)(w * 16 + d) * 64 + lane) * 8) = o;
    }
}
__device__ __forceinline__ void ret_scan(Frame& F, int nblk) {
    for (int gt = F.vcu * NTHR + F.tid; gt < 65536; gt += nblk * NTHR) {
    const int bh = gt >> 13, off = gt & 8191, h = bh & 3;
    const float cd = exp2f(128.0f * ret_lg2(h));
    u32x4* p = (u32x4*)(F.ws + WS_SF) + (size_t)bh * 32 * 8192 + off;
    float s[8];
#pragma unroll
    for (int e = 0; e < 8; ++e) s[e] = 0.f;
#pragma unroll 8
    for (int n = 0; n < 32; ++n) {
        const u32x4 kv = __builtin_nontemporal_load(p + (size_t)n * 8192);
        u32x4 o; o.x = cvtpk(s[0], s[1]); o.y = cvtpk(s[2], s[3]); o.z = cvtpk(s[4], s[5]); o.w = cvtpk(s[6], s[7]);
        __builtin_nontemporal_store(o, p + (size_t)n * 8192);
        s[0] = s[0] * cd + bflo(kv.x); s[1] = s[1] * cd + bfhi(kv.x); s[2] = s[2] * cd + bflo(kv.y); s[3] = s[3] * cd + bfhi(kv.y);
        s[4] = s[4] * cd + bflo(kv.z); s[5] = s[5] * cd + bfhi(kv.z); s[6] = s[6] * cd + bflo(kv.w); s[7] = s[7] * cd + bfhi(kv.w);
    }
    }
}
__device__ __forceinline__ void ret_out_unit(Frame& F, int unit) {
    const int n = unit & 31, bh = unit >> 5, h = bh & 3, b = bh >> 2;
    const bf16_t* Z = (const bf16_t*)(F.ws + WS_Z);
    const size_t row0 = (size_t)b * SEQ + (size_t)n * 128;
    const float lg2 = ret_lg2(h);
    LAS unsigned char* Kt = F.lds; LAS unsigned char* Vt = F.lds + 128 * RK_PITCH;
    const int w = F.wave, lane = F.lane, li = lane & 15, g = lane >> 4, q = li >> 2, p = li & 3;
    const int c0 = 16 * w; const size_t myrow = row0 + c0 + li;
    const bf16_t* zq = Z + myrow * ZC + ZO_Q + 256 * h;
    bf16x8 qn[8];
    f32x4 acc[16];
#pragma unroll
    for (int d = 0; d < 16; ++d) acc[d] = (f32x4){0.f, 0.f, 0.f, 0.f};
    if (n > 0) {
        const u32x4* SFv = (const u32x4*)((const bf16_t*)(F.ws + WS_SF) + (size_t)unit * 65536);
        u32x4 stg[16];
#pragma unroll
        for (int i = 0; i < 16; ++i) stg[i] = SFv[F.tid + NTHR * i];
        bf16x8 qp[8];
#pragma unroll
        for (int ks = 0; ks < 8; ++ks) {
            const s16x4 lo = *(const s16x4*)(zq + 32 * ks + 4 * g), hi = *(const s16x4*)(zq + 32 * ks + 16 + 4 * g);
            qp[ks] = PK8(lo, hi);
        }
#pragma unroll
        for (int i = 0; i < 16; ++i) *(LAS u32x4*)(F.lds + (F.tid + NTHR * i) * 16) = stg[i];
        __syncthreads();
#pragma unroll
        for (int d = 0; d < 16; ++d)
#pragma unroll
            for (int ks = 0; ks < 8; ++ks) {
                const bf16x8 a = *(const LAS bf16x8*)(F.lds + ((ks * 16 + d) * 64 + lane) * 16);
                acc[d] = __builtin_amdgcn_mfma_f32_16x16x32_bf16(a, qp[ks], acc[d], 0, 0, 0);
            }
        const float xi = exp2f((float)(c0 + li + 1) * lg2);
#pragma unroll
        for (int d = 0; d < 16; ++d) acc[d] *= xi;
        __syncthreads();
    }
#pragma unroll
    for (int i = 0; i < 8; ++i) {
        const int e = F.tid + NTHR * i, row = e >> 5, ch = e & 31;
        const bf16_t* zr = Z + (row0 + row) * ZC + 256 * h + 8 * ch;
        *(LAS u32x4*)(Kt + row * RK_PITCH + ch * 16) = *(const u32x4*)(zr + ZO_K);
        *(LAS u32x4*)(Vt + row * RV_PITCH + ch * 16) = *(const u32x4*)(zr + ZO_V);
    }
#pragma unroll
    for (int ks = 0; ks < 8; ++ks) qn[ks] = *(const bf16x8*)(zq + 32 * ks + 8 * g);
    __syncthreads();
    for (int st2 = 0; 2 * st2 <= w; ++st2) {
        f32x4 X0 = {0.f, 0.f, 0.f, 0.f}, X1 = {0.f, 0.f, 0.f, 0.f};
        const bool has1 = (2 * st2 + 1 <= w);
        const LAS unsigned char* kb = Kt + (32 * st2 + li) * RK_PITCH + (8 * g) * 2;
#pragma unroll
        for (int ks = 0; ks < 8; ++ks) X0 = __builtin_amdgcn_mfma_f32_16x16x32_bf16(*(const LAS bf16x8*)(kb + ks * 64), qn[ks], X0, 0, 0, 0);
        if (has1) {
#pragma unroll
            for (int ks = 0; ks < 8; ++ks) X1 = __builtin_amdgcn_mfma_f32_16x16x32_bf16(*(const LAS bf16x8*)(kb + 16 * RK_PITCH + ks * 64), qn[ks], X1, 0, 0, 0);
        }
        const int cl = c0 + li;
#pragma unroll
        for (int i = 0; i < 4; ++i) {
            const int d0 = cl - (32 * st2 + 4 * g + i), d1 = d0 - 16;
            X0[i] = d0 >= 0 ? X0[i] * exp2f((float)d0 * lg2) : 0.f;
            X1[i] = (has1 && d1 >= 0) ? X1[i] * exp2f((float)d1 * lg2) : 0.f;
        }
        u32x4 pbu; pbu.x = cvtpk(X0[0], X0[1]); pbu.y = cvtpk(X0[2], X0[3]); pbu.z = cvtpk(X1[0], X1[1]); pbu.w = cvtpk(X1[2], X1[3]);
        const bf16x8 pb = __builtin_bit_cast(bf16x8, pbu);
        const LAS unsigned char* vb = Vt + (32 * st2 + 4 * g + q) * RV_PITCH + (4 * p) * 2;
#pragma unroll
        for (int d = 0; d < 16; ++d) {
            const s16x4 lo = trread(vb + d * 32), hi = trread(vb + d * 32 + 16 * RV_PITCH);
            const bf16x8 a = PK8(lo, hi);
            acc[d] = __builtin_amdgcn_mfma_f32_16x16x32_bf16(a, pb, acc[d], 0, 0, 0);
        }
    }
    float s = 0.f;
#pragma unroll
    for (int d = 0; d < 16; ++d) s += (acc[d][0] + acc[d][1]) + (acc[d][2] + acc[d][3]);
    s += __shfl_xor(s, 16); s += __shfl_xor(s, 32);
    const float mean = s * (1.0f / 256.0f);
    float qv = 0.f;
#pragma unroll
    for (int d = 0; d < 16; ++d) { const f32x4 dd = acc[d] - mean; qv += (dd[0] * dd[0] + dd[1] * dd[1]) + (dd[2] * dd[2] + dd[3] * dd[3]); }
    qv += __shfl_xor(qv, 16); qv += __shfl_xor(qv, 32);
    const float rstd = rsqrtf(qv * (1.0f / 256.0f) + 1e-5f);
    bf16_t* Y = (bf16_t*)(F.ws + WS_Y);
#pragma unroll
    for (int d = 0; d < 16; ++d) {
        const int col = 256 * h + 16 * d + 4 * g;
        const u32x2 gz = *(const u32x2*)(Z + myrow * ZC + ZO_G + col);
        const f32x4 o = (acc[d] - mean) * rstd;
        u32x2 wv; wv.x = cvtpk(o[0] * siluf_(bflo(gz.x)), o[1] * siluf_(bfhi(gz.x))); wv.y = cvtpk(o[2] * siluf_(bflo(gz.y)), o[3] * siluf_(bfhi(gz.y)));
        *(u32x2*)(Y + myrow * 2048 + col) = wv;
    }
    __syncthreads();
}

template <int ACT> __device__ __forceinline__ bf16x8 shift_frag(const bf16_t* Z, size_t row, bool has_prev, int zcol, const float* mu) {
    const u32x4 cu = *(const u32x4*)(Z + row * ZC + zcol);
    u32x4 pv = {0u, 0u, 0u, 0u}; if (has_prev) pv = *(const u32x4*)(Z + (row - 1) * ZC + zcol);
    const f32x4 m0 = *(const f32x4*)(mu + (zcol - ZO_RW)), m1 = *(const f32x4*)(mu + (zcol - ZO_RW) + 4);
    float v[8]; const unsigned cw[4] = {cu.x, cu.y, cu.z, cu.w}, pw[4] = {pv.x, pv.y, pv.z, pv.w};
#pragma unroll
    for (int e = 0; e < 4; ++e) {
        const float c0 = bflo(cw[e]), c1 = bfhi(cw[e]), p0 = bflo(pw[e]), p1 = bfhi(pw[e]);
        const float mm0 = (e < 2) ? m0[2 * e] : m1[2 * e - 4], mm1 = (e < 2) ? m0[2 * e + 1] : m1[2 * e - 3];
        v[2 * e] = c0 + (p0 - c0) * mm0; v[2 * e + 1] = c1 + (p1 - c1) * mm1;
    }
#pragma unroll
    for (int e = 0; e < 8; ++e) { if (ACT == 1) v[e] = 2.0f * __builtin_amdgcn_rcpf(1.0f + __expf(-2.0f * v[e])) - 1.0f; if (ACT == 2) v[e] = sigmoidf_(v[e]); }
    u32x4 o; o.x = cvtpk(v[0], v[1]); o.y = cvtpk(v[2], v[3]); o.z = cvtpk(v[4], v[5]); o.w = cvtpk(v[6], v[7]);
    return __builtin_bit_cast(bf16x8, o);
}
__device__ __forceinline__ void shift8(const bf16_t* Z, size_t row, bool has_prev, int zcol, const float* mu, float (&v)[8]) {
    const u32x4 cu = *(const u32x4*)(Z + row * ZC + zcol);
    u32x4 pv = {0u, 0u, 0u, 0u}; if (has_prev) pv = *(const u32x4*)(Z + (row - 1) * ZC + zcol);
    const f32x4 m0 = *(const f32x4*)(mu + (zcol - ZO_RW)), m1 = *(const f32x4*)(mu + (zcol - ZO_RW) + 4);
    const unsigned cw[4] = {cu.x, cu.y, cu.z, cu.w}, pw[4] = {pv.x, pv.y, pv.z, pv.w};
#pragma unroll
    for (int e = 0; e < 4; ++e) {
        const float c0 = bflo(cw[e]), c1 = bfhi(cw[e]), p0 = bflo(pw[e]), p1 = bfhi(pw[e]);
        const float mm0 = (e < 2) ? m0[2 * e] : m1[2 * e - 4], mm1 = (e < 2) ? m0[2 * e + 1] : m1[2 * e - 3];
        v[2 * e] = c0 + (p0 - c0) * mm0; v[2 * e + 1] = c1 + (p1 - c1) * mm1;
    }
}

constexpr size_t RWC_QTF = 0, RWC_NTF = 16 * MiB, RWC_RWF = 32 * MiB, RWC_Y0F = 48 * MiB;
constexpr size_t WS_XF = WS_U;
constexpr size_t WS_P63 = WS_U + 16 * MiB;
constexpr size_t WS_BON = WS_U + 17 * MiB;
constexpr size_t WS_SG = WS_U + 18 * MiB;
constexpr int TP = 144;
constexpr int T_AT = 0, T_BT = 9216, T_KT = 18432, T_RT = 27648, T_VV = 36864, T_AAB = 46080, T_AAK = 55296, T_RB = 64512, T_RK = 73728, T_WW = 82944, T_U0 = 92160;
constexpr int F_PD = 101376, F_PI = 117760, F_SEG = 134144, F_P63 = 136192, F_DIAG = 136448, F_DT = F_DIAG + 4096;
__device__ __forceinline__ bf16x8 rowfrag(const LAS unsigned char* tile, int row, int s, int g) { return *(const LAS bf16x8*)(tile + row * TP + (32 * s + 8 * g) * 2); }
__device__ __forceinline__ bf16x8 permfrag(const LAS unsigned char* tile, int row, int s, int g) {
    const s16x4 lo = *(const LAS s16x4*)(tile + row * TP + (32 * s + 4 * g) * 2), hi = *(const LAS s16x4*)(tile + row * TP + (32 * s + 16 + 4 * g) * 2); return PK8(lo, hi);
}
__device__ __forceinline__ bf16x8 trfrag(const LAS unsigned char* tile, int s, int col0, int g, int q, int p) {
    const LAS unsigned char* a = tile + (32 * s + 8 * g + q) * TP + (col0 + 4 * p) * 2;
    const s16x4 lo = trread(a), hi = trread(a + 4 * TP); return PK8(lo, hi);
}
__device__ __forceinline__ unsigned short f2bf1(float f) { return (unsigned short)(cvtpk(f, 0.f) & 0xffffu); }
__device__ __forceinline__ bf16x8 pack8(const f32x4& a, const f32x4& b) { u32x4 o; o.x = cvtpk(a[0], a[1]); o.y = cvtpk(a[2], a[3]); o.z = cvtpk(b[0], b[1]); o.w = cvtpk(b[2], b[3]); return __builtin_bit_cast(bf16x8, o); }
__device__ __forceinline__ bf16x8 pack4z(const f32x4& a) { u32x4 o; o.x = cvtpk(a[0], a[1]); o.y = cvtpk(a[2], a[3]); o.z = 0u; o.w = 0u; return __builtin_bit_cast(bf16x8, o); }

__device__ __forceinline__ void rwkv_chunk_unit(Frame& F, int bunit) {
    const int hg = bunit & 1, n = (bunit >> 1) & 63, b = bunit >> 7;
    const bf16_t* Z = (const bf16_t*)(F.ws + WS_Z); const float* mu = IN_F(10);
    const bf16_t* lt = (const bf16_t*)(F.ws + WS_LORA);
    const size_t row0 = (size_t)b * SEQ + (size_t)n * 64;
    const int w = F.wave, lane = F.lane, li = lane & 15, g = lane >> 4, q = li >> 2, p = li & 3;
    LAS unsigned char* lds = F.lds;
    bf16x8 af[3];
    {
        const int mat = w >> 2, tt = w & 3;
        const size_t row = row0 + 16 * tt + li; const bool hp = (n * 64 + 16 * tt + li) > 0;
#pragma unroll
        for (int ks = 0; ks < 3; ++ks) af[ks] = mat == 0 ? shift_frag<1>(Z, row, hp, ZO_ZW + 32 * ks + 8 * g, mu) : shift_frag<0>(Z, row, hp, ZO_ZA + 32 * ks + 8 * g, mu);
    }
    {
        const int t = F.tid >> 3, c0 = hg * 128 + (F.tid & 7) * 16;
        const size_t row = row0 + t; const bool hp = (n * 64 + t) > 0;
        bf16_t* sg = (bf16_t*)(F.ws + WS_SG) + row * 256 + c0;
        *(bf16x8*)sg = shift_frag<2>(Z, row, hp, ZO_ZG + c0, mu);
        *(bf16x8*)(sg + 8) = shift_frag<2>(Z, row, hp, ZO_ZG + c0 + 8, mu);
    }
#define RW_S0(h_) do { const int mat_ = w >> 2, tt_ = w & 3; const bf16_t* wt_ = lt + (size_t)mat_ * 1024 * 96; LAS float* pre_ = (LAS float*)(lds + (mat_ == 0 ? F_PD : F_PI)); \
        _Pragma("unroll") for (int ct_ = 0; ct_ < 4; ++ct_) { f32x4 acc_ = {0.f, 0.f, 0.f, 0.f}; \
            _Pragma("unroll") for (int ks_ = 0; ks_ < 3; ++ks_) { const bf16x8 bfr_ = *(const bf16x8*)(wt_ + (size_t)((h_) * 64 + 16 * ct_ + li) * 96 + 32 * ks_ + 8 * g); \
                acc_ = __builtin_amdgcn_mfma_f32_16x16x32_bf16(af[ks_], bfr_, acc_, 0, 0, 0); } \
            _Pragma("unroll") for (int i_ = 0; i_ < 4; ++i_) pre_[(16 * tt_ + 4 * g + i_) * 64 + 16 * ct_ + li] = acc_[i_]; } } while (0)
#define RW_ZLOAD(h_) do { const bf16_t* zb_ = Z + (row0 + 8 * w) * ZC + (h_) * 64 + lane; const bool hp_ = (n * 64 + 8 * w) > 0; \
        zr[0] = hp_ ? *(zb_ - ZC + ZO_R) : (bf16_t)0; zk[0] = hp_ ? *(zb_ - ZC + ZO_KW) : (bf16_t)0; zv[0] = hp_ ? *(zb_ - ZC + ZO_VW) : (bf16_t)0; \
        _Pragma("unroll") for (int j_ = 0; j_ < 8; ++j_) { zr[j_ + 1] = zb_[(size_t)j_ * ZC + ZO_R]; zk[j_ + 1] = zb_[(size_t)j_ * ZC + ZO_KW]; zv[j_ + 1] = zb_[(size_t)j_ * ZC + ZO_VW]; } } while (0)
    {
        for (int e = F.tid; e < 4 * 6 * 256; e += NTHR) {
            const int mt = e >> 8, el = e & 255, m = mt / 6, k6 = mt % 6, tt = (k6 >= 5) ? 2 : (k6 >= 3) ? 1 : 0, ct = (k6 >= 5) ? 3 : (k6 >= 3) ? (k6 - 3 + 2) : (k6 + 1);
            *(LAS unsigned short*)(lds + (m == 0 ? T_AAB : m == 1 ? T_AAK : m == 2 ? T_RB : T_RK) + (16 * tt + (el >> 4)) * TP + (16 * ct + (el & 15)) * 2) = 0;
        }
    }
    bf16_t zr[9], zk[9], zv[9];
    RW_ZLOAD(hg * 8);
    RW_S0(hg * 8);
    for (int hh = 0; hh < 8; ++hh) {
    const int h = hg * 8 + hh, unit = (b * 16 + h) * 64 + n;
    __syncthreads();
    float aj[8], bj[8], kmj[8], rj[8], vj[8], lwj[8], Lj[8];
    {
        const int c = lane, hc = h * 64 + c;
        const float w0 = IN_F(11)[hc], a0 = IN_F(13)[hc], k_k = IN_F(16)[hc], k_a = IN_F(17)[hc], r_k = IN_F(18)[hc];
        const float mur = mu[hc], muk = mu[1024 + hc], muv = mu[2048 + hc];
        const LAS float* PD = (const LAS float*)(lds + F_PD); const LAS float* PI = (const LAS float*)(lds + F_PI);
        float pr = bf2f(zr[0]), pk = bf2f(zk[0]), pvv = bf2f(zv[0]);
        float bonv[8], run = 0.f;
#pragma unroll
        for (int j = 0; j < 8; ++j) {
            const float cr = bf2f(zr[j + 1]), ck = bf2f(zk[j + 1]), cv = bf2f(zv[j + 1]);
            const float r = cr + (pr - cr) * mur, kw = ck + (pk - ck) * muk, vw = cv + (pvv - cv) * muv;
            pr = cr; pk = ck; pvv = cv;
            const float y = -(w0 + PD[(8 * w + j) * 64 + c]);
            const float sp = fmaxf(y, 0.f) + __logf(1.0f + __expf(-fabsf(y)));
            const float lw = -__expf(-sp - 0.5f);
            const float icl = sigmoidf_(a0 + PI[(8 * w + j) * 64 + c]);
            const float kkr = kw * k_k;
            const float inv = __builtin_amdgcn_rsqf(fmaxf(wave_sum(kkr * kkr), 1e-24f));
            const float kk = kkr * inv, km = kw * (1.0f + (icl - 1.0f) * k_a);
            bonv[j] = wave_sum(r * km * r_k);
            aj[j] = -kk; bj[j] = kk * icl; kmj[j] = km; rj[j] = r; vj[j] = vw; lwj[j] = lw; run += lw; Lj[j] = run;
        }
        ((LAS float*)(lds + F_SEG))[w * 64 + c] = run;
        if (lane < 8) { float bsel = bonv[0];
#pragma unroll
            for (int j = 1; j < 8; ++j) bsel = (lane == j) ? bonv[j] : bsel;
            ((float*)(F.ws + WS_BON))[(size_t)unit * 64 + 8 * w + lane] = bsel; }
    }
    __syncthreads();
    {
        const int c = lane; const LAS float* SEG = (const LAS float*)(lds + F_SEG);
        float off = 0.f, tot = 0.f;
#pragma unroll
        for (int ww = 0; ww < 8; ++ww) { const float sgv = SEG[ww * 64 + c]; tot += sgv; off += (ww < w) ? sgv : 0.f; }
        if (w == 0) { const float p63 = __expf(tot); ((LAS float*)(lds + F_P63))[c] = p63; ((float*)(F.ws + WS_P63))[(size_t)unit * 64 + c] = p63; }
#pragma unroll
        for (int j = 0; j < 8; ++j) {
            const float L = off + Lj[j], e1 = __expf(L - lwj[j]), e2 = __expf(-L), e3 = __builtin_amdgcn_rcpf(e2);
            const int to = (8 * w + j) * TP + c * 2;
            *(LAS unsigned short*)(lds + T_AT + to) = f2bf1(aj[j] * e1);
            *(LAS unsigned short*)(lds + T_BT + to) = f2bf1(bj[j] * e2);
            *(LAS unsigned short*)(lds + T_KT + to) = f2bf1(kmj[j] * e2);
            *(LAS unsigned short*)(lds + T_RT + to) = f2bf1(rj[j] * e3);
            *(LAS unsigned short*)(lds + T_VV + to) = f2bf1(vj[j]);
        }
    }
    if (hh < 7) { RW_ZLOAD(h + 1); RW_S0(h + 1); }
    __syncthreads();
    if (w == 0) {
#pragma unroll
        for (int tt = 0; tt < 4; ++tt) {
            f32x4 acc = {0.f, 0.f, 0.f, 0.f};
            acc = __builtin_amdgcn_mfma_f32_16x16x32_bf16(rowfrag(lds + T_AT, 16 * tt + li, 0, g), rowfrag(lds + T_BT, 16 * tt + li, 0, g), acc, 0, 0, 0);
            acc = __builtin_amdgcn_mfma_f32_16x16x32_bf16(rowfrag(lds + T_AT, 16 * tt + li, 1, g), rowfrag(lds + T_BT, 16 * tt + li, 1, g), acc, 0, 0, 0);
#pragma unroll
            for (int e = 0; e < 4; ++e) {
                const float v = (li < 4 * g + e) ? acc[e] : 0.f;
                ((LAS float*)(lds + F_DIAG))[(tt * 16 + 4 * g + e) * 16 + li] = v;
                *(LAS unsigned short*)(lds + T_AAB + (16 * tt + 4 * g + e) * TP + (16 * tt + li) * 2) = f2bf1(v);
            }
        }
        asm volatile("s_waitcnt lgkmcnt(0)" ::: "memory");
        const int bb = lane >> 4, jc = li; const LAS float* DG = (const LAS float*)(lds + F_DIAG) + bb * 256;
        float Tr[16];
#pragma unroll
        for (int r = 0; r < 16; ++r) {
            float acc0 = (r == jc) ? 1.f : 0.f, acc1 = 0.f;
#pragma unroll
            for (int i = 0; i < r; ++i) { if (i & 1) acc1 += DG[r * 16 + i] * Tr[i]; else acc0 += DG[r * 16 + i] * Tr[i]; }
            Tr[r] = acc0 + acc1;
        }
#pragma unroll
        for (int r = 0; r < 16; ++r) *(LAS unsigned short*)(lds + F_DT + ((bb * 16 + r) * 16 + jc) * 2) = f2bf1(Tr[r]);
    } else {
        for (int job = w - 1; job < 36; job += 7) {
            int m, tt, ct;
            if (job < 6) { m = 0; tt = (job >= 3) ? 3 : (job >= 1) ? 2 : 1; ct = job - ((tt - 1) * tt) / 2; }
            else { const int idx = job - 6, r = idx % 10; m = 1 + idx / 10; tt = (r >= 6) ? 3 : (r >= 3) ? 2 : (r >= 1) ? 1 : 0; ct = r - (tt * (tt + 1)) / 2; }
            const LAS unsigned char* srcA = lds + ((m < 2) ? T_AT : T_RT); const LAS unsigned char* srcB = lds + ((m & 1) ? T_KT : T_BT);
            LAS unsigned char* dst = lds + (m == 0 ? T_AAB : m == 1 ? T_AAK : m == 2 ? T_RB : T_RK);
            f32x4 acc = {0.f, 0.f, 0.f, 0.f};
            acc = __builtin_amdgcn_mfma_f32_16x16x32_bf16(rowfrag(srcA, 16 * tt + li, 0, g), rowfrag(srcB, 16 * ct + li, 0, g), acc, 0, 0, 0);
            acc = __builtin_amdgcn_mfma_f32_16x16x32_bf16(rowfrag(srcA, 16 * tt + li, 1, g), rowfrag(srcB, 16 * ct + li, 1, g), acc, 0, 0, 0);
            if (ct == tt) {
#pragma unroll
                for (int e = 0; e < 4; ++e) { const bool keep = (m >= 2) ? (li <= 4 * g + e) : (li < 4 * g + e); acc[e] = keep ? acc[e] : 0.f; }
            }
#pragma unroll
            for (int e = 0; e < 4; ++e) *(LAS unsigned short*)(dst + (16 * tt + 4 * g + e) * TP + (16 * ct + li) * 2) = f2bf1(acc[e]);
        }
    }
    __syncthreads();
    f32x4 av[4];
#pragma unroll
    for (int i = 0; i < 4; ++i) av[i] = (f32x4){0.f, 0.f, 0.f, 0.f};
    if (w >= 4) {
        const int ct = w - 4;
        const bf16x8 v0 = trfrag(lds + T_VV, 0, 16 * ct, g, q, p), v1 = trfrag(lds + T_VV, 1, 16 * ct, g, q, p);
#pragma unroll
        for (int tt = 0; tt < 4; ++tt) {
            av[tt] = __builtin_amdgcn_mfma_f32_16x16x32_bf16(rowfrag(lds + T_AAK, 16 * tt + li, 0, g), v0, av[tt], 0, 0, 0);
            av[tt] = __builtin_amdgcn_mfma_f32_16x16x32_bf16(rowfrag(lds + T_AAK, 16 * tt + li, 1, g), v1, av[tt], 0, 0, 0);
        }
    }
    {
        const int cs = w & 3; const bool isU = w >= 4;
        f32x4 X[4];
#pragma unroll
        for (int bb = 0; bb < 4; ++bb) {
            f32x4 acc;
            if (isU) acc = av[bb];
            else {
#pragma unroll
                for (int e = 0; e < 4; ++e) acc[e] = bf2f(*(const LAS unsigned short*)(lds + T_AT + (16 * bb + 4 * g + e) * TP + (16 * cs + li) * 2));
            }
            if (bb >= 1) {
                const f32x4 zz = {0.f, 0.f, 0.f, 0.f};
                acc = __builtin_amdgcn_mfma_f32_16x16x32_bf16(permfrag(lds + T_AAB, 16 * bb + li, 0, g), pack8(X[0], bb >= 2 ? X[1] : zz), acc, 0, 0, 0);
            }
            if (bb == 3) acc = __builtin_amdgcn_mfma_f32_16x16x32_bf16(permfrag(lds + T_AAB, 16 * bb + li, 1, g), pack4z(X[2]), acc, 0, 0, 0);
            const s16x4 dlo = *(const LAS s16x4*)(lds + F_DT + ((bb * 16 + li) * 16 + 4 * g) * 2);
            const bf16x8 ad = (bf16x8){dlo[0], dlo[1], dlo[2], dlo[3], 0, 0, 0, 0};
            X[bb] = __builtin_amdgcn_mfma_f32_16x16x32_bf16(ad, pack4z(acc), (f32x4){0.f, 0.f, 0.f, 0.f}, 0, 0, 0);
        }
        LAS unsigned char* dst = lds + (isU ? T_U0 : T_WW);
#pragma unroll
        for (int bb = 0; bb < 4; ++bb)
#pragma unroll
            for (int e = 0; e < 4; ++e) *(LAS unsigned short*)(dst + (16 * bb + 4 * g + e) * TP + (16 * cs + li) * 2) = f2bf1(X[bb][e]);
    }
    __syncthreads();
    {
        const int ct = w & 3;
        unsigned char* co = (unsigned char*)F.out;
        if (w < 4) {
            {
                const bf16x8 b0 = trfrag(lds + T_BT, 0, 16 * ct, g, q, p), b1 = trfrag(lds + T_BT, 1, 16 * ct, g, q, p);
                const float pc = ((const LAS float*)(lds + F_P63))[16 * ct + li];
                f32x4 acc[4];
#pragma unroll
                for (int tt = 0; tt < 4; ++tt) {
                    acc[tt] = __builtin_amdgcn_mfma_f32_16x16x32_bf16(trfrag(lds + T_WW, 0, 16 * tt, g, q, p), b0, (f32x4){0.f, 0.f, 0.f, 0.f}, 0, 0, 0);
                    acc[tt] = __builtin_amdgcn_mfma_f32_16x16x32_bf16(trfrag(lds + T_WW, 1, 16 * tt, g, q, p), b1, acc[tt], 0, 0, 0);
                    acc[tt] *= pc;
                }
                bf16x8* o = (bf16x8*)(co + RWC_QTF + (size_t)unit * 8192) + (ct * 2) * 64 + lane;
                o[0] = pack8(acc[0], acc[1]); o[64] = pack8(acc[2], acc[3]);
            }
            {
                const bf16x8 u0 = trfrag(lds + T_U0, 0, 16 * ct, g, q, p), u1 = trfrag(lds + T_U0, 1, 16 * ct, g, q, p);
                const bf16x8 v0 = trfrag(lds + T_VV, 0, 16 * ct, g, q, p), v1 = trfrag(lds + T_VV, 1, 16 * ct, g, q, p);
                f32x4 acc[4];
#pragma unroll
                for (int tt = 0; tt < 4; ++tt) {
                    acc[tt] = __builtin_amdgcn_mfma_f32_16x16x32_bf16(trfrag(lds + T_BT, 0, 16 * tt, g, q, p), u0, (f32x4){0.f, 0.f, 0.f, 0.f}, 0, 0, 0);
                    acc[tt] = __builtin_amdgcn_mfma_f32_16x16x32_bf16(trfrag(lds + T_BT, 1, 16 * tt, g, q, p), u1, acc[tt], 0, 0, 0);
                    acc[tt] = __builtin_amdgcn_mfma_f32_16x16x32_bf16(trfrag(lds + T_KT, 0, 16 * tt, g, q, p), v0, acc[tt], 0, 0, 0);
                    acc[tt] = __builtin_amdgcn_mfma_f32_16x16x32_bf16(trfrag(lds + T_KT, 1, 16 * tt, g, q, p), v1, acc[tt], 0, 0, 0);
                    acc[tt] *= *(const LAS f32x4*)(lds + F_P63 + (16 * tt + 4 * g) * 4);
                }
                bf16x8* o = (bf16x8*)(co + RWC_NTF + (size_t)unit * 8192) + (ct * 64 + lane) * 2;
                o[0] = pack8(acc[0], acc[1]); o[1] = pack8(acc[2], acc[3]);
            }
        } else {
            const bf16x8 rb0 = rowfrag(lds + T_RB, 16 * ct + li, 0, g), rb1 = rowfrag(lds + T_RB, 16 * ct + li, 1, g);
            {
                f32x4 acc[4];
#pragma unroll
                for (int tt = 0; tt < 4; ++tt) {
                    const s16x4 r4 = *(const LAS s16x4*)(lds + T_RT + (16 * ct + li) * TP + (16 * tt + 4 * g) * 2);
#pragma unroll
                    for (int e = 0; e < 4; ++e) acc[tt][e] = bf2f((unsigned short)r4[e]);
                    acc[tt] = __builtin_amdgcn_mfma_f32_16x16x32_bf16(trfrag(lds + T_WW, 0, 16 * tt, g, q, p), rb0, acc[tt], 0, 0, 0);
                    acc[tt] = __builtin_amdgcn_mfma_f32_16x16x32_bf16(trfrag(lds + T_WW, 1, 16 * tt, g, q, p), rb1, acc[tt], 0, 0, 0);
                }
                bf16x8* o = (bf16x8*)(co + RWC_RWF + (size_t)unit * 8192) + (ct * 2) * 64 + lane;
                o[0] = pack8(acc[0], acc[1]); o[64] = pack8(acc[2], acc[3]);
            }
            {
                const bf16x8 rk0 = rowfrag(lds + T_RK, 16 * ct + li, 0, g), rk1 = rowfrag(lds + T_RK, 16 * ct + li, 1, g);
                f32x4 acc[4];
#pragma unroll
                for (int tt = 0; tt < 4; ++tt) {
                    acc[tt] = __builtin_amdgcn_mfma_f32_16x16x32_bf16(trfrag(lds + T_U0, 0, 16 * tt, g, q, p), rb0, (f32x4){0.f, 0.f, 0.f, 0.f}, 0, 0, 0);
                    acc[tt] = __builtin_amdgcn_mfma_f32_16x16x32_bf16(trfrag(lds + T_U0, 1, 16 * tt, g, q, p), rb1, acc[tt], 0, 0, 0);
                    acc[tt] = __builtin_amdgcn_mfma_f32_16x16x32_bf16(trfrag(lds + T_VV, 0, 16 * tt, g, q, p), rk0, acc[tt], 0, 0, 0);
                    acc[tt] = __builtin_amdgcn_mfma_f32_16x16x32_bf16(trfrag(lds + T_VV, 1, 16 * tt, g, q, p), rk1, acc[tt], 0, 0, 0);
                }
                bf16x8* o = (bf16x8*)(co + RWC_Y0F + (size_t)unit * 8192) + (ct * 64 + lane) * 2;
                o[0] = pack8(acc[0], acc[1]); o[1] = pack8(acc[2], acc[3]);
            }
        }
    }
    }
#undef RW_S0
#undef RW_ZLOAD
}
constexpr int SC_R = 8, SC_D = 6, SC_SLOT = 16896;
__device__ __forceinline__ void rwkv_scan_block(Frame& F, int bh) {
    const int lane = F.lane, g = lane >> 4, w = F.wave;
    LAS unsigned char* lds = F.lds;
    const unsigned char* co = (const unsigned char*)F.out;
    const size_t u0 = (size_t)bh * 64;
    if (w >= 4) {
        const int j = w - 4;
#define SC_ISSUE(m_) do { const size_t un_ = u0 + (m_); LAS unsigned char* sl_ = lds + ((m_) % SC_R) * SC_SLOT; \
            const unsigned char* q_ = co + RWC_QTF + un_ * 8192 + lane * 16; const unsigned char* n_ = co + RWC_NTF + un_ * 8192 + (j * 64 + lane) * 32; \
            __builtin_amdgcn_global_load_lds((const unsigned*)(q_ + (2 * j) * 1024), (LAS unsigned*)(sl_ + (2 * j) * 1024), 16, 0, 0); \
            __builtin_amdgcn_global_load_lds((const unsigned*)(q_ + (2 * j + 1) * 1024), (LAS unsigned*)(sl_ + (2 * j + 1) * 1024), 16, 0, 0); \
            __builtin_amdgcn_global_load_lds((const unsigned*)(n_), (LAS unsigned*)(sl_ + 8192 + (2 * j) * 1024), 16, 0, 0); \
            __builtin_amdgcn_global_load_lds((const unsigned*)(n_ + 16), (LAS unsigned*)(sl_ + 8192 + (2 * j + 1) * 1024), 16, 0, 0); \
            __builtin_amdgcn_global_load_lds((const unsigned*)(F.ws + WS_P63 + (un_ * 64 + lane) * 4), (LAS unsigned*)(sl_ + 16384), 4, 0, 0); } while (0)
#pragma unroll
        for (int m = 0; m < SC_D; ++m) SC_ISSUE(m);
        for (int n = 0; n < 64; ++n) {
            if (n + SC_D <= 64) asm volatile("s_waitcnt vmcnt(25)" ::: "memory"); else asm volatile("s_waitcnt vmcnt(0)" ::: "memory");
            __builtin_amdgcn_s_barrier();
            if (n + SC_D < 64) SC_ISSUE(n + SC_D);
        }
#undef SC_ISSUE
        asm volatile("s_waitcnt vmcnt(0)" ::: "memory");
    } else {
        const int vs = w;
        f32x4 X[4];
#pragma unroll
        for (int i = 0; i < 4; ++i) X[i] = (f32x4){0.f, 0.f, 0.f, 0.f};
        for (int n = 0; n < 64; ++n) {
            __builtin_amdgcn_s_barrier();
            asm volatile("" ::: "memory");
            const LAS unsigned char* sl = lds + (n % SC_R) * SC_SLOT;
            bf16x8 qa[4][2]; f32x4 pv[4];
#pragma unroll
            for (int kt = 0; kt < 4; ++kt) { qa[kt][0] = *(const LAS bf16x8*)(sl + (kt * 2) * 1024 + lane * 16); qa[kt][1] = *(const LAS bf16x8*)(sl + (kt * 2 + 1) * 1024 + lane * 16); pv[kt] = *(const LAS f32x4*)(sl + 16384 + (16 * kt + 4 * g) * 4); }
            const u32x4 n0 = *(const LAS u32x4*)(sl + 8192 + (vs * 2) * 1024 + lane * 16), n1 = *(const LAS u32x4*)(sl + 8192 + (vs * 2 + 1) * 1024 + lane * 16);
            const bf16x8 xb0 = pack8(X[0], X[1]), xb1 = pack8(X[2], X[3]);
            bf16x8* xo = (bf16x8*)(F.ws + WS_XF + (u0 + n) * 8192) + (vs * 2) * 64 + lane;
            xo[0] = xb0; xo[64] = xb1;
            const unsigned nw[8] = {n0.x, n0.y, n0.z, n0.w, n1.x, n1.y, n1.z, n1.w};
#pragma unroll
            for (int kt = 0; kt < 4; ++kt) {
                f32x4 acc; acc[0] = pv[kt][0] * X[kt][0] + bflo(nw[2 * kt]); acc[1] = pv[kt][1] * X[kt][1] + bfhi(nw[2 * kt]); acc[2] = pv[kt][2] * X[kt][2] + bflo(nw[2 * kt + 1]); acc[3] = pv[kt][3] * X[kt][3] + bfhi(nw[2 * kt + 1]);
                acc = __builtin_amdgcn_mfma_f32_16x16x32_bf16(qa[kt][0], xb0, acc, 0, 0, 0);
                acc = __builtin_amdgcn_mfma_f32_16x16x32_bf16(qa[kt][1], xb1, acc, 0, 0, 0);
                X[kt] = acc;
            }
            asm volatile("s_waitcnt lgkmcnt(0)" ::: "memory");
        }
    }
    __syncthreads();
}
__device__ __forceinline__ void rwkv_out_wave(Frame& F, int unit) {
    const int n = unit & 63, bh = unit >> 6, h = bh & 15, b = bh >> 4;
    const int lane = F.lane, li = lane & 15, g = lane >> 4;
    const bf16_t* Z = (const bf16_t*)(F.ws + WS_Z); const float* mu = IN_F(10);
    const bf16_t* wg = (const bf16_t*)(F.ws + WS_LORA) + 2 * 1024 * 96;
    const unsigned char* co = (const unsigned char*)F.out;
    const bf16x8* xf = (const bf16x8*)(F.ws + WS_XF + (size_t)unit * 8192) + lane;
    bf16x8 xa[4][2];
#pragma unroll
    for (int vt = 0; vt < 4; ++vt) { xa[vt][0] = xf[(vt * 2) * 64]; xa[vt][1] = xf[(vt * 2 + 1) * 64]; }
    const float* lnw = IN_F(19) + h * 64; const float* lnb = IN_F(20) + h * 64;
#pragma unroll
    for (int tt = 0; tt < 4; ++tt) {
        const size_t row = (size_t)b * SEQ + (size_t)n * 64 + 16 * tt + li; const bool hp = (n * 64 + 16 * tt + li) > 0;
        const bf16x8* rf = (const bf16x8*)(co + RWC_RWF + (size_t)unit * 8192) + (tt * 2) * 64 + lane;
        const bf16x8 r0 = rf[0], r1 = rf[64];
        const bf16x8* yf = (const bf16x8*)(co + RWC_Y0F + (size_t)unit * 8192) + (tt * 64 + lane) * 2;
        const u32x4 y0 = __builtin_bit_cast(u32x4, yf[0]), y1 = __builtin_bit_cast(u32x4, yf[1]);
        const unsigned yw[8] = {y0.x, y0.y, y0.z, y0.w, y1.x, y1.y, y1.z, y1.w};
        f32x4 ya[4];
#pragma unroll
        for (int vt = 0; vt < 4; ++vt) {
            f32x4 acc; acc[0] = bflo(yw[2 * vt]); acc[1] = bfhi(yw[2 * vt]); acc[2] = bflo(yw[2 * vt + 1]); acc[3] = bfhi(yw[2 * vt + 1]);
            acc = __builtin_amdgcn_mfma_f32_16x16x32_bf16(xa[vt][0], r0, acc, 0, 0, 0);
            ya[vt] = __builtin_amdgcn_mfma_f32_16x16x32_bf16(xa[vt][1], r1, acc, 0, 0, 0);
        }
        float s = 0.f;
#pragma unroll
        for (int vt = 0; vt < 4; ++vt) s += (ya[vt][0] + ya[vt][1]) + (ya[vt][2] + ya[vt][3]);
        s += __shfl_xor(s, 16); s += __shfl_xor(s, 32);
        const float mean = s * (1.0f / 64.0f); float qv = 0.f;
#pragma unroll
        for (int vt = 0; vt < 4; ++vt) { const f32x4 d = ya[vt] - mean; qv += (d[0] * d[0] + d[1] * d[1]) + (d[2] * d[2] + d[3] * d[3]); }
        qv += __shfl_xor(qv, 16); qv += __shfl_xor(qv, 32);
        const float rstd = rsqrtf(qv * (1.0f / 64.0f) + 64e-5f);
        const float bon = ((const float*)(F.ws + WS_BON))[(size_t)unit * 64 + 16 * tt + li];
#pragma unroll
        for (int vt = 0; vt < 4; ++vt) {
            const int vc = 16 * vt + 4 * g, zc = ZO_VW + h * 64 + vc;
            const u32x2 cu = *(const u32x2*)(Z + row * ZC + zc); u32x2 pu = {0u, 0u}; if (hp) pu = *(const u32x2*)(Z + (row - 1) * ZC + zc);
            const f32x4 m4 = *(const f32x4*)(mu + (zc - ZO_RW)), w4 = *(const f32x4*)(lnw + vc), b4 = *(const f32x4*)(lnb + vc);
            f32x4 vw; { const float c0 = bflo(cu.x), c1 = bfhi(cu.x), c2 = bflo(cu.y), c3 = bfhi(cu.y);
                vw[0] = c0 + (bflo(pu.x) - c0) * m4[0]; vw[1] = c1 + (bfhi(pu.x) - c1) * m4[1]; vw[2] = c2 + (bflo(pu.y) - c2) * m4[2]; vw[3] = c3 + (bfhi(pu.y) - c3) * m4[3]; }
            bf16_t* yp = (bf16_t*)(F.ws + WS_Y) + row * 2048 + 1024 + h * 64 + vc;
            const u32x2 gu = *(const u32x2*)yp; const f32x4 gv = {bflo(gu.x), bfhi(gu.x), bflo(gu.y), bfhi(gu.y)};
            const f32x4 o = (((ya[vt] - mean) * rstd) * w4 + b4 + vw * bon) * gv;
            u32x2 wv; wv.x = cvtpk(o[0], o[1]); wv.y = cvtpk(o[2], o[3]);
            *(u32x2*)yp = wv;
        }
    }
}

struct Args { const float* in[26]; float* out; unsigned char* ws; int ph_lo, ph_hi, li, pad; };
constexpr int N_PHASES = 12;
#ifndef MK_ONE_LAUNCH
#define MK_ONE_LAUNCH 1
#endif

__global__ void __launch_bounds__(NTHR, 2) fwd_kernel(Args args) {
    extern __shared__ __attribute__((aligned(16))) unsigned char lds_raw[];
    Frame F;
    F.lds = (LAS unsigned char*)lds_raw;
    F.MISC = (volatile LAS unsigned*)(F.lds + MISC_OFF);
    F.tid = threadIdx.x; F.lane = F.tid & 63; F.wave = __builtin_amdgcn_readfirstlane(F.tid >> 6);
    F.G = gridDim.x; { const int bx = blockIdx.x; F.vcu = (F.G % 8 == 0) ? (bx % 8) * (F.G / 8) + bx / 8 : bx; }
    F.in = args.in; F.out = args.out; F.ws = args.ws; F.ctl = (unsigned*)(args.ws + WS_CTL);
    for (int u = F.tid; u < (LDS_BYTES - LDSCTL_OFF) / 4; u += NTHR) ((LAS unsigned*)(F.lds + LDSCTL_OFF))[u] = 0u;
    __syncthreads();
    XcdBarrier bar; bar.bar = F.ctl + CW_BAR; bar.x = 0; bar.st = nullptr;
    if (MK_ONE_LAUNCH) bar = xcd_barrier_post(F.ctl + CW_BAR, F.MISC + 8);
    const int lo = args.ph_lo, hi = args.ph_hi;
#ifndef PHMASK
#define PHMASK 0xFFF
#endif
#define IN(k) (((PHMASK >> (k)) & 1) && lo <= (k) && (k) < hi)
#ifndef DUPMASK
#define DUPMASK 0x0
#endif
#define REP(k) _Pragma("unroll") for (int rep_ = 0; rep_ < (((DUPMASK >> (k)) & 1) ? 2 : 1); ++rep_)
#define DUPN(k) (((DUPMASK >> (k)) & 1) ? 2 : 1)
#define SEAM(k) do { if (IN(k)) xcd_barrier(bar); } while (0)
    float* mod = (float*)(F.ctl + CW_MOD);
    bf16_t* U = (bf16_t*)(F.ws + WS_U); bf16_t* Zb = (bf16_t*)(F.ws + WS_Z); bf16_t* Yb = (bf16_t*)(F.ws + WS_Y);

    if (IN(0)) {
        p0_ada(F, 1.0f);
        if (F.vcu >= 192) p0_small(F, 192);
        { const int gw_ = F.vcu * NWAVES + F.wave, NGW_ = F.G * NWAVES; p0_transposes(F, TR_WIN_LO, TR_WIN_HI - TR_WIN_LO, gw_, NGW_); }
        p0_wait_ada(F, 48u * 4u);
        norm_mod_rows(F, IN_F(0), IN_F(5), 2048, 0, U);
    } SEAM(1);
    if (IN(2)) REP(2) {
        pg8::Gemm g{U, (const bf16_t*)(F.ws + WS_WIN), M, ZC, D, D, D, 0}; pg8::StaticOrder S; S.init(M, ZC, F.G, (int)blockIdx.x);
        pg8::EpiZ E{Zb, (const float*)(F.ws + WS_ROPE), (const float*)(F.ws + WS_ROPE) + (size_t)M * 128, IN_F(9)};
        pg8::gemm_phase<pg8::EpiZ, true, true>(F.lds, g, S, E);
        constexpr int NU_ = (M / 256) * (ZC / 256), TAIL0_ = NU_ % 256;
        if (TAIL0_ != 0 && (int)blockIdx.x >= TAIL0_) p0_transposes(F, TR_MO_LO, TR_MO_HI - TR_MO_LO, ((int)blockIdx.x - TAIL0_) * NWAVES + F.wave, (256 - TAIL0_) * NWAVES);
    } SEAM(2);
    if (IN(3)) { for (int u = F.vcu; u < 256 * DUPN(3); u += F.G) ret_kv_unit(F, u & 255); for (int u = F.vcu; u < 256 * DUPN(12); u += F.G) rwkv_chunk_unit(F, u & 255); } SEAM(3);
    if (IN(4)) {
        constexpr int F1A = 3072;
        if (F.vcu < 96) { ret_scan(F, 96); p0_transposes(F, TR_F1_LO + F1A, (TR_F1_HI - TR_F1_LO) - F1A, F.vcu * NWAVES + F.wave, 96 * NWAVES); }
        else if (F.vcu < 128) rwkv_scan_block(F, F.vcu - 96);
        else {
            pg8::Gemm g{(const bf16_t*)(F.ws + WS_SG), (const bf16_t*)(F.ws + WS_LORA) + 2 * 1024 * 96, M, 1024, 256, 256, 256, 0};
            pg8::StaticOrder S; S.init(M, 1024, F.G - 128, F.vcu - 128);
            pg8::EpiPlain<2048, 1024> E{Yb}; pg8::gemm_phase<pg8::EpiPlain<2048, 1024>, false, true>(F.lds, g, S, E);
            p0_transposes(F, TR_F1_LO, F1A, (F.vcu - 128) * NWAVES + F.wave, 128 * NWAVES);
        }
    } SEAM(4);
    if (IN(5)) { for (int u = F.vcu; u < 256 * DUPN(5); u += F.G) ret_out_unit(F, u & 255); for (int u = F.vcu * NWAVES + F.wave; u < 2048 * DUPN(13); u += F.G * NWAVES) rwkv_out_wave(F, u & 2047); } SEAM(5);
    if (IN(6)) REP(6) {
        pg8::StaticOrder S; S.init(M, D, F.G, (int)blockIdx.x);
        pg8::Gemm g{Yb, (const bf16_t*)(F.ws + WS_WMRG), M, D, D, D, D, 16};
        pg8::EpiMerge E{Zb, U}; pg8::gemm_phase<pg8::EpiMerge, false, true>(F.lds, g, S, E);
    } SEAM(6);
    if (IN(7)) {
        pg8::Gemm g{U, (const bf16_t*)(F.ws + WS_WO), M, D, D, D, D, 0}; pg8::StaticOrder S; S.init(M, D, F.G, (int)blockIdx.x);
        if (DUPN(7) == 2) { pg8::EpiNull E0; pg8::gemm_phase<pg8::EpiNull, false, true>(F.lds, g, S, E0); }
        pg8::EpiResNorm<0> E{IN_F(0), F.out, mod + 4096, IN_F(6), mod + 6144, U, (float*)(F.ws + WS_ROPE), F.ctl + CW_CNT};
        pg8::gemm_phase<pg8::EpiResNorm<0>, false, true>(F.lds, g, S, E);
    } SEAM(7);
    if (IN(9)) REP(9) {
        pg8::Gemm g{U, (const bf16_t*)(F.ws + WS_WF1), M, FF2, D, D, D, 0}; pg8::StaticOrder S; S.init(M, FF2, F.G, (int)blockIdx.x);
        pg8::EpiSwiglu E{Zb}; pg8::gemm_phase<pg8::EpiSwiglu, true, true>(F.lds, g, S, E);
        constexpr int NU_ = (M / 256) * (FF2 / 256), TAIL0_ = NU_ % 256;
        if (TAIL0_ != 0 && (int)blockIdx.x >= TAIL0_) p0_transposes(F, TR_F2_LO, TR_F2_HI - TR_F2_LO, ((int)blockIdx.x - TAIL0_) * NWAVES + F.wave, (256 - TAIL0_) * NWAVES);
    } SEAM(9);
    if (IN(10)) {
        pg8::Gemm g{Zb, (const bf16_t*)(F.ws + WS_WF2), M, D, FFH, FFH, FFH, 0}; pg8::StaticOrder S; S.init(M, D, F.G, (int)blockIdx.x);
        if (DUPN(10) == 2) { pg8::EpiNull E0; pg8::gemm_phase<pg8::EpiNull, false, true>(F.lds, g, S, E0); }
        pg8::EpiResNorm<1> E{F.out, F.out, mod + 10240, IN_F(7), mod, nullptr, (float*)(F.ws + WS_ROPE) + 8 * 8192, F.ctl + CW_CNT + 32 * 64};
        pg8::gemm_phase<pg8::EpiResNorm<1>, false, true>(F.lds, g, S, E);
    }
#undef IN
#undef SEAM
}

extern "C" void kernel_launch(void* const* d_in, const int* in_sizes, int n_in, void* d_out, int out_size, void* d_ws, size_t ws_size, hipStream_t stream) {
    static int grid = 0;
    if (grid == 0) {
        if (n_in != 26 || out_size != M * D || ws_size < WS_END) { fprintf(stderr, "kernel_launch: unexpected shapes n_in %d out %d ws %zu\n", n_in, out_size, ws_size); grid = -1; return; }
        int dev = 0, cus = 0, per_cu = 0;
        if (hipGetDevice(&dev) != hipSuccess || hipDeviceGetAttribute(&cus, hipDeviceAttributeMultiprocessorCount, dev) != hipSuccess) { grid = -1; return; }
        if (hipFuncSetAttribute((const void*)fwd_kernel, hipFuncAttributeMaxDynamicSharedMemorySize, LDS_BYTES) != hipSuccess) { fprintf(stderr, "kernel_launch: hipFuncSetAttribute failed\n"); grid = -1; return; }
        if (hipOccupancyMaxActiveBlocksPerMultiprocessor(&per_cu, (const void*)fwd_kernel, NTHR, LDS_BYTES) != hipSuccess || per_cu < 1) { fprintf(stderr, "kernel_launch: occupancy query says %d\n", per_cu); per_cu = 1; }
        (void)hipGetLastError();
        grid = cus;
    }
    if (grid < 0) return;
    (void)hipMemsetAsync((char*)d_ws + WS_CTL, 0, CTL_ZERO_BYTES, stream);
    Args a{};
    for (int i = 0; i < 26; ++i) a.in[i] = (const float*)d_in[i];
    a.out = (float*)d_out; a.ws = (unsigned char*)d_ws;
#if MK_ONE_LAUNCH
    a.ph_lo = 0; a.ph_hi = N_PHASES; a.li = 0;
    hipLaunchKernelGGL(fwd_kernel, dim3(grid), dim3(NTHR), LDS_BYTES, stream, a);
#else
    for (int p = 0; p < N_PHASES; ++p) { a.ph_lo = p; a.ph_hi = p + 1; a.li = p; hipLaunchKernelGGL(fwd_kernel, dim3(grid), dim3(NTHR), LDS_BYTES, stream, a); }
#endif
}
```

```cpp
#include <hip/hip_runtime.h>
#include <cstdio>
#include <cstdint>

#define GAS __attribute__((address_space(1)))
#define LAS __attribute__((address_space(3)))
typedef unsigned short bf16_t;
typedef short bf16x8 __attribute__((ext_vector_type(8)));
typedef short s16x4 __attribute__((ext_vector_type(4)));
typedef float f32x4 __attribute__((ext_vector_type(4)));
typedef float f32x2 __attribute__((ext_vector_type(2)));
typedef unsigned u32x4 __attribute__((ext_vector_type(4)));
typedef unsigned u32x2 __attribute__((ext_vector_type(2)));
typedef __bf16 bf16x2_t __attribute__((ext_vector_type(2)));

constexpr int BATCH = 2, SEQ = 4096, M = BATCH * SEQ, D = 2048;
constexpr int ZC = 11776;
constexpr int ZO_Q = 0, ZO_K = 1024, ZO_V = 2048, ZO_G = 3072, ZO_RW = 4096, ZO_R = 4096, ZO_KW = 5120, ZO_VW = 6144, ZO_ZW = 7168, ZO_ZA = 7264, ZO_ZG = 7360, ZO_GATE = 7680;
constexpr int IN_COLS = 11712, FFH = 5632, FF2 = 2 * FFH;
constexpr int NWAVES = 8, NTHR = 512;
constexpr float NORM_EPS = 1e-6f;

constexpr size_t MiB = 1u << 20;
constexpr size_t WS_CTL = 0, CTL_ZERO_BYTES = 256 * 1024;
constexpr size_t WS_WIN = 1 * MiB;
constexpr size_t WS_U = 47 * MiB;
constexpr size_t WS_WMRG = 79 * MiB;
constexpr size_t WS_WO = 87 * MiB;
constexpr size_t WS_WF1 = 95 * MiB;
constexpr size_t WS_WF2 = 139 * MiB;
constexpr size_t WS_LORA = 161 * MiB;
constexpr size_t WS_ROPE = 162 * MiB;
constexpr size_t WS_Y = 170 * MiB;
constexpr size_t WS_Z = 202 * MiB;
constexpr size_t WS_END = 386 * MiB;
constexpr size_t WS_SF = WS_WIN;
constexpr int CW_TMO = 0, CW_CODE = 1, CW_ADA = 64, CW_Q0 = 128, CW_Q1 = 192, CW_Q2 = 256, CW_Q3 = 320, CW_PANEL = 1024, CW_DRET = 2048, CW_DSCAN = 2304, CW_DGATE = 3072, CW_BAR = 4096, CW_CNT = 8192, CW_MOD = 16384, CW_RSS1 = 49152, CW_RSS2 = 57344;

constexpr int RING_BYTES = 143360;
constexpr int LDSCTL_OFF = RING_BYTES, MISC_OFF = LDSCTL_OFF + 320;
constexpr int LDS_BYTES = 147456;

#define RLX_AGENT __ATOMIC_RELAXED, __HIP_MEMORY_SCOPE_AGENT
#define LDS_WAIT() asm volatile("s_waitcnt lgkmcnt(0)" ::: "memory")
#define VM_WAIT() asm volatile("s_waitcnt vmcnt(0)" ::: "memory")
__device__ __forceinline__ unsigned cvtpk(float lo, float hi) { f32x2 v = {lo, hi}; bf16x2_t b = __builtin_convertvector(v, bf16x2_t); return __builtin_bit_cast(unsigned, b); }
__device__ __forceinline__ float bflo(unsigned u) { return __uint_as_float(u << 16); }
__device__ __forceinline__ float bfhi(unsigned u) { return __uint_as_float(u & 0xffff0000u); }
__device__ __forceinline__ float bf2f(bf16_t b) { return __uint_as_float((unsigned)b << 16); }
__device__ __forceinline__ float sigmoidf_(float x) { return __builtin_amdgcn_rcpf(1.0f + __expf(-x)); }
__device__ __forceinline__ float siluf_(float x) { return x * __builtin_amdgcn_rcpf(1.0f + __expf(-x)); }
template <int CTRL> __device__ __forceinline__ float dppf(float v) { return __uint_as_float((unsigned)__builtin_amdgcn_update_dpp(0, (int)__float_as_uint(v), CTRL, 0xf, 0xf, true)); }
__device__ __forceinline__ float row_sum16(float v) {
    v += dppf<0xB1>(v); v += dppf<0x4E>(v); v += dppf<0x141>(v); v += dppf<0x140>(v); return v;
}
__device__ __forceinline__ float wave_sum(float v) {
    v = row_sum16(v);
    const unsigned u = __float_as_uint(v);
    return (__uint_as_float(__builtin_amdgcn_readlane(u, 0)) + __uint_as_float(__builtin_amdgcn_readlane(u, 16))) + (__uint_as_float(__builtin_amdgcn_readlane(u, 32)) + __uint_as_float(__builtin_amdgcn_readlane(u, 48)));
}
__device__ __forceinline__ s16x4 trread(const LAS unsigned char* p) {
    typedef short v4i16_t __attribute__((ext_vector_type(4)));
    return __builtin_bit_cast(s16x4, __builtin_amdgcn_ds_read_tr16_b64_v4i16((LAS v4i16_t*)p));
}
#define PK8(lo, hi) (bf16x8){lo[0], lo[1], lo[2], lo[3], hi[0], hi[1], hi[2], hi[3]}

#define XB_TMO      128
#define XB_XCNT(j)  (256  + 64 * (j))
#define XB_XSUB(j)  (1280 + 64 * (j))
#define XB_XGEN(j)  (2304 + 64 * (j))
#define XB_TOP      3328
#define XB_TOPGEN   3392
#define XCD_BAR_WORDS 3456
#define XB_SPIN_CAP (1u << 20)
__device__ __forceinline__ unsigned xb_ld(unsigned* p)              { return __hip_atomic_load(p, __ATOMIC_RELAXED, __HIP_MEMORY_SCOPE_AGENT); }
__device__ __forceinline__ unsigned xb_add(unsigned* p, unsigned v) { return __hip_atomic_fetch_add(p, v, __ATOMIC_RELAXED, __HIP_MEMORY_SCOPE_AGENT); }
__device__ __forceinline__ unsigned xb_xcc_id() { return (unsigned)__builtin_amdgcn_s_getreg((3 << 11) | 20) & 0xFu; }
#define XB_SPIN(cond, bar) do { unsigned _sp = 0; while (cond) { __builtin_amdgcn_s_sleep(1); \
    if ((++_sp & 255u) == 0u) { if (xb_ld(&(bar)[XB_TMO])) break; if (_sp > XB_SPIN_CAP) { atomicAdd(&(bar)[XB_TMO], 1u); break; } } } } while (0)
struct XcdBarrier { unsigned* bar; unsigned x; volatile LAS unsigned* st; };
__device__ __forceinline__ XcdBarrier xcd_barrier_post(unsigned* bar, volatile LAS unsigned* st) {
    XcdBarrier b; b.bar = bar; b.x = xb_xcc_id(); b.st = st;
    if (threadIdx.x == 0) (void)xb_add(&bar[XB_XCNT(b.x)], 1u);
    return b;
}
__device__ __forceinline__ void xcd_barrier_complete(unsigned* bar, unsigned x, unsigned& nloc, unsigned& nx) {
    const unsigned G = gridDim.x * gridDim.y * gridDim.z;
    unsigned sum, cnt, mine, sp = 0u;
    for (;;) {
        sum = 0u; cnt = 0u; mine = 0u;
#pragma unroll
        for (unsigned j = 0; j < 16; ++j) { const unsigned c = xb_ld(&bar[XB_XCNT(j)]); sum += c; cnt += (c > 0u) ? 1u : 0u; mine = (j == x) ? c : mine; }
        if (sum == G) break;
        __builtin_amdgcn_s_sleep(1);
        if ((++sp & 255u) == 0u) { if (xb_ld(&bar[XB_TMO])) break; if (sp > XB_SPIN_CAP) { atomicAdd(&bar[XB_TMO], 1u); break; } }
    }
    nloc = mine > 0u ? mine : 1u; nx = cnt > 0u ? cnt : 1u;
}
__device__ __forceinline__ void xcd_barrier(const XcdBarrier& b) {
    asm volatile("s_waitcnt vmcnt(0)" ::: "memory");
    __syncthreads();
    if (threadIdx.x == 0) {
        unsigned* bar = b.bar;
        __builtin_amdgcn_s_waitcnt(0);
        unsigned nloc = b.st[0], nx = b.st[1];
        if (nloc == 0u) { xcd_barrier_complete(bar, b.x, nloc, nx); b.st[0] = nloc; b.st[1] = nx; }
        const unsigned old = xb_add(&bar[XB_XSUB(b.x)], 1u);
        const unsigned gen = old / nloc;
        if (old + 1u == (gen + 1u) * nloc) {
            __builtin_amdgcn_fence(__ATOMIC_RELEASE, "agent");
            asm volatile("s_waitcnt vmcnt(0)" ::: "memory");
            const unsigned og = xb_add(&bar[XB_TOP], 1u);
            const unsigned tg = og / nx;
            if (og + 1u == (tg + 1u) * nx) xb_add(&bar[XB_TOPGEN], 1u);
            else XB_SPIN(xb_ld(&bar[XB_TOPGEN]) == tg, bar);
            __builtin_amdgcn_fence(__ATOMIC_ACQUIRE, "agent");
            xb_add(&bar[XB_XGEN(b.x)], 1u);
            asm volatile("s_waitcnt vmcnt(0)" ::: "memory");
        } else {
            { const unsigned rank = old - gen * nloc + 1u; if (rank == (nloc >> 1) || rank == nloc - (nloc >> 3)) asm volatile("buffer_wbl2 sc1" ::: "memory"); }
            XB_SPIN(xb_ld(&bar[XB_XGEN(b.x)]) == gen, bar);
            __builtin_amdgcn_fence(__ATOMIC_ACQUIRE, "agent");
            asm volatile("s_waitcnt vmcnt(0)" ::: "memory");
        }
    }
    __syncthreads();
}

__device__ __forceinline__ void panel_barrier(unsigned* cnt, unsigned target) {
    asm volatile("s_waitcnt vmcnt(0)" ::: "memory");
    __syncthreads();
    if (threadIdx.x == 0) {
        __builtin_amdgcn_fence(__ATOMIC_RELEASE, "agent");
        asm volatile("s_waitcnt vmcnt(0)" ::: "memory");
        (void)__hip_atomic_fetch_add(cnt, 1u, __ATOMIC_RELAXED, __HIP_MEMORY_SCOPE_AGENT);
        unsigned sp = 0;
        while (__hip_atomic_load(cnt, __ATOMIC_RELAXED, __HIP_MEMORY_SCOPE_AGENT) < target) { __builtin_amdgcn_s_sleep(2); if (++sp > (1u << 22)) break; }
        __builtin_amdgcn_fence(__ATOMIC_ACQUIRE, "agent");
        asm volatile("s_waitcnt vmcnt(0)" ::: "memory");
    }
    __syncthreads();
}

__device__ __forceinline__ void dep_signal(unsigned* c0, unsigned* c1) {
    asm volatile("s_waitcnt vmcnt(0)" ::: "memory");
    __syncthreads();
    if (threadIdx.x == 0) {
        __builtin_amdgcn_fence(__ATOMIC_RELEASE, "agent");
        asm volatile("s_waitcnt vmcnt(0)" ::: "memory");
        (void)__hip_atomic_fetch_add(c0, 1u, __ATOMIC_RELAXED, __HIP_MEMORY_SCOPE_AGENT);
        if (c1) (void)__hip_atomic_fetch_add(c1, 1u, __ATOMIC_RELAXED, __HIP_MEMORY_SCOPE_AGENT);
    }
}
__device__ __forceinline__ void dep_wait3(unsigned* c0, unsigned t0, unsigned* c1, unsigned t1, unsigned* c2, unsigned t2) {
    if (threadIdx.x == 0) {
        unsigned sp = 0;
        while (__hip_atomic_load(c0, __ATOMIC_RELAXED, __HIP_MEMORY_SCOPE_AGENT) < t0 || (c1 && __hip_atomic_load(c1, __ATOMIC_RELAXED, __HIP_MEMORY_SCOPE_AGENT) < t1) ||
               (c2 && __hip_atomic_load(c2, __ATOMIC_RELAXED, __HIP_MEMORY_SCOPE_AGENT) < t2)) { __builtin_amdgcn_s_sleep(4); if (++sp > (1u << 22)) break; }
        __builtin_amdgcn_fence(__ATOMIC_ACQUIRE, "agent");
        asm volatile("s_waitcnt vmcnt(0)" ::: "memory");
    }
    __syncthreads();
}

namespace pg8 {
constexpr int BM = 256, BK = 64, HALF = 128, HTB = HALF * BK * 2, STAGE_BYTES = 8 * HTB, NXCD = 8, WGM = 8;
__host__ __device__ __forceinline__ int lds_byte(int r, int c) { const int st = (r >> 4) * 2 + (c >> 5), rr = r & 15, cc = c & 31, ob = rr * 64 + cc * 2; return st * 1024 + (ob ^ (((ob >> 9) & 1) << 5)); }
__host__ __device__ __forceinline__ void stage_rc(int b, int& R, int& C) { const int st = b / 1024, sb = b % 1024, swz = sb ^ (((sb >> 9) & 1) << 5); R = (st >> 1) * 16 + swz / 64; C = (st & 1) * 32 + (swz % 64) / 2; }
__host__ __device__ __forceinline__ int perm32(int rho) { const int n = rho >> 4, i = rho & 15; return 8 * (i >> 2) + 4 * n + (i & 3); }
struct Unit { int pm, pn; };
struct Gemm { const bf16_t* A; const bf16_t* Bt; int M, N, K, lda, ldb, tmid; };
__host__ __device__ __forceinline__ int zperm46(int p) { if (p < 23) return p < 4 ? p : (p < 15 ? p + 4 : p + 15); const int q = p - 23; return q < 4 ? q + 4 : (q < 15 ? q + 15 : q + 23); }
struct StaticOrder {
    int nM, nN, nwg, G, c, zp;
    __device__ void init(int M_, int N_, int G_, int c_) { nM = M_ / BM; nN = N_ / BM; nwg = nM * nN; G = G_; c = c_; zp = 0; }
    __device__ bool next(int i, Unit& u) const {
        const long L = (long)i * G + c; if (L >= nwg) return false;
        int wgid = (int)L; { const int q = nwg / NXCD, r = nwg % NXCD, xcd = wgid % NXCD, off = wgid / NXCD; wgid = (xcd < r ? xcd * (q + 1) : r * (q + 1) + (xcd - r) * q) + off; }
        const int nig = WGM * nN, gid = wgid / nig, fm = gid * WGM, gsz = (nM - fm) < WGM ? (nM - fm) : WGM;
        u.pm = fm + ((wgid % nig) % gsz); u.pn = (wgid % nig) / gsz; if (zp) u.pn = zperm46(u.pn); return true;
    }
};
template <class Epi, bool ALIGN_EPI, bool SP2>
__device__ __forceinline__ void gemm_phase(LAS unsigned char* lds, const Gemm g, const StaticOrder& S, const Epi& E) {
    const int tid = threadIdx.x, wid = __builtin_amdgcn_readfirstlane(tid >> 6), lane = tid & 63, wr = wid >> 2, wc = wid & 3, fr = lane & 15, fq = lane >> 4;
    const int K = g.K, nt = K / BK;
    unsigned voffA[2], voffB[2];
#pragma unroll
    for (int i = 0; i < 2; ++i) { int R, C; stage_rc(tid * 16 + i * 8192, R, C); const int Rb = Epi::PERM ? ((R & ~31) + perm32(R & 31)) : R;
        voffA[i] = (unsigned)(R * g.lda + C) * 2u; voffB[i] = (unsigned)(Rb * g.ldb + C) * 2u; }
    const size_t kstep = (size_t)(BK * 2);
    const size_t hstepA = (size_t)HALF * g.lda * 2, hstepB = (size_t)HALF * g.ldb * 2;
    const size_t tstepA = 2 * hstepA, tstepB = 2 * hstepB;
    const unsigned ldsw = (unsigned)wid * 1024u;
    const int aoff = lds_byte(wr * 64 + fr, fq * 8), boff = lds_byte(wc * 32 + fr, fq * 8);
#define PG8_SA(b, h) (((b) * 2 + (h)) * HTB)
#define PG8_SB(b, h) ((4 + (b) * 2 + (h)) * HTB)
#define PG8_STAGE(bufoff, gbase, voff) do { _Pragma("unroll") for (int _i = 0; _i < 2; ++_i) \
        __builtin_amdgcn_global_load_lds((const unsigned*)((const char*)(gbase) + (voff)[_i]), (LAS unsigned*)(lds + (bufoff) + ldsw + _i * 8192), 16, 0, 0); } while (0)
#define PG8_LDA(dst, b, h) do { _Pragma("unroll") for (int m = 0; m < 4; ++m) _Pragma("unroll") for (int k = 0; k < 2; ++k) dst[m][k] = *(const LAS bf16x8*)(lds + PG8_SA(b, h) + aoff + m * 2048 + k * 1024); } while (0)
#define PG8_LDB(dst, b, h) do { _Pragma("unroll") for (int n = 0; n < 2; ++n) _Pragma("unroll") for (int k = 0; k < 2; ++k) dst[n][k] = *(const LAS bf16x8*)(lds + PG8_SB(b, h) + boff + n * 2048 + k * 1024); } while (0)
#define PG8_MMA(ai, bj, At, Bt) do { __builtin_amdgcn_s_setprio(1); _Pragma("unroll") for (int m = 0; m < 4; ++m) _Pragma("unroll") for (int n = 0; n < 2; ++n) _Pragma("unroll") for (int k = 0; k < 2; ++k) \
        acc[ai][bj][m][n] = __builtin_amdgcn_mfma_f32_16x16x32_bf16(Bt[n][k], At[m][k], acc[ai][bj][m][n], 0, 0, 0); __builtin_amdgcn_s_setprio(0); } while (0)
#define PG8_WAIT_V(n) asm volatile("s_waitcnt vmcnt(" #n ")" ::: "memory")
#define PG8_WAIT_L(n) asm volatile("s_waitcnt lgkmcnt(" #n ")" ::: "memory")
#define PG8_BAR __builtin_amdgcn_s_barrier()
#define PG8_SCHED __builtin_amdgcn_sched_barrier(0)
    Unit cur, nxt; int ui = 0;
    if (!S.next(0, cur)) return;
    f32x4 acc[2][2][4][2];
#pragma unroll
    for (int a = 0; a < 2; ++a)
#pragma unroll
        for (int b = 0; b < 2; ++b)
#pragma unroll
            for (int m = 0; m < 4; ++m)
#pragma unroll
                for (int n = 0; n < 2; ++n) acc[a][b][m][n] = (f32x4){0.f, 0.f, 0.f, 0.f};
    bf16x8 At[4][2], B0[2][2], B1[2][2];
    const char* cA = (const char*)g.A + (size_t)cur.pm * tstepA; const char* cB = (const char*)g.Bt + (size_t)cur.pn * tstepB;
    if constexpr (SP2) {
        PG8_STAGE(PG8_SB(0, 0), cB, voffB); PG8_STAGE(PG8_SB(0, 1), cB + hstepB, voffB); PG8_STAGE(PG8_SA(0, 0), cA, voffA); PG8_STAGE(PG8_SA(0, 1), cA + hstepA, voffA);
        if (wr == 1) PG8_BAR;
        PG8_WAIT_V(2); PG8_BAR;
        PG8_STAGE(PG8_SB(1, 0), cB + kstep, voffB); PG8_STAGE(PG8_SA(1, 0), cA + kstep, voffA); PG8_STAGE(PG8_SB(1, 1), cB + hstepB + kstep, voffB);
        PG8_WAIT_V(6); PG8_BAR;
    } else {
        PG8_STAGE(PG8_SB(0, 0), cB, voffB); PG8_STAGE(PG8_SA(0, 0), cA, voffA); PG8_STAGE(PG8_SB(0, 1), cB + hstepB, voffB); PG8_STAGE(PG8_SA(0, 1), cA + hstepA, voffA);
        if (wr == 1) PG8_BAR;
        PG8_WAIT_V(4); PG8_BAR;
        PG8_STAGE(PG8_SB(1, 0), cB + kstep, voffB); PG8_STAGE(PG8_SA(1, 0), cA + kstep, voffA); PG8_STAGE(PG8_SB(1, 1), cB + hstepB + kstep, voffB);
        PG8_WAIT_V(6); PG8_BAR;
    }
    for (;;) {
        const bool has_next = S.next(ui + 1, nxt);
        const char* nA = has_next ? (const char*)g.A + (size_t)nxt.pm * tstepA : cA; const char* nB = has_next ? (const char*)g.Bt + (size_t)nxt.pn * tstepB : cB;
        for (int t = 0; t < nt; t += 2) {
            if constexpr (Epi::HAS_MID) { if (t == g.tmid) E.mid(acc, cur, wr, wc, fr, fq); }
            const bool last = (t == nt - 2);
            const char* a1 = cA + (size_t)(t + 1) * kstep;
            const char* a2 = last ? nA : cA + (size_t)(t + 2) * kstep; const char* b2 = last ? nB : cB + (size_t)(t + 2) * kstep;
            const char* a3 = a2 + kstep; const char* b3 = b2 + kstep;
            if constexpr (SP2) {
            PG8_LDB(B0, 0, 0); PG8_LDB(B1, 0, 1); PG8_SCHED; PG8_LDA(At, 0, 0); PG8_STAGE(PG8_SA(1, 1), a1 + hstepA, voffA);
            PG8_WAIT_V(8); PG8_WAIT_L(0); PG8_BAR; PG8_MMA(0, 0, At, B0); PG8_MMA(0, 1, At, B1); PG8_BAR; PG8_SCHED;
            PG8_LDA(At, 0, 1); PG8_STAGE(PG8_SB(0, 0), b2, voffB); PG8_STAGE(PG8_SB(0, 1), b2 + hstepB, voffB); PG8_STAGE(PG8_SA(0, 0), a2, voffA);
            PG8_WAIT_V(8); PG8_WAIT_L(0); PG8_BAR; PG8_MMA(1, 0, At, B0); PG8_MMA(1, 1, At, B1); PG8_BAR; PG8_SCHED;
            PG8_LDB(B0, 1, 0); PG8_LDB(B1, 1, 1); PG8_SCHED; PG8_LDA(At, 1, 0); PG8_STAGE(PG8_SA(0, 1), a2 + hstepA, voffA);
            PG8_WAIT_V(8); PG8_WAIT_L(0); PG8_BAR; PG8_MMA(0, 0, At, B0); PG8_MMA(0, 1, At, B1); PG8_BAR; PG8_SCHED;
            PG8_LDA(At, 1, 1); PG8_STAGE(PG8_SB(1, 0), b3, voffB); PG8_STAGE(PG8_SB(1, 1), b3 + hstepB, voffB); PG8_STAGE(PG8_SA(1, 0), a3, voffA);
            PG8_WAIT_V(8); PG8_WAIT_L(0); PG8_BAR; PG8_MMA(1, 0, At, B0); PG8_MMA(1, 1, At, B1); PG8_BAR; PG8_SCHED;
            } else {
            PG8_LDB(B0, 0, 0); PG8_SCHED; PG8_LDA(At, 0, 0); PG8_STAGE(PG8_SA(1, 1), a1 + hstepA, voffA);
            PG8_WAIT_L(8); PG8_BAR; PG8_WAIT_L(0); PG8_MMA(0, 0, At, B0); PG8_BAR; PG8_SCHED;
            PG8_LDB(B1, 0, 1); PG8_STAGE(PG8_SB(0, 0), b2, voffB);
            PG8_BAR; PG8_WAIT_L(0); PG8_MMA(0, 1, At, B1); PG8_BAR;
            PG8_LDA(At, 0, 1); PG8_STAGE(PG8_SA(0, 0), a2, voffA);
            PG8_BAR; PG8_WAIT_L(0); PG8_MMA(1, 0, At, B0); PG8_BAR; PG8_SCHED;
            PG8_STAGE(PG8_SB(0, 1), b2 + hstepB, voffB);
            PG8_WAIT_V(6); PG8_BAR; PG8_MMA(1, 1, At, B1); PG8_BAR;
            PG8_LDB(B0, 1, 0); PG8_SCHED; PG8_LDA(At, 1, 0); PG8_STAGE(PG8_SA(0, 1), a2 + hstepA, voffA);
            PG8_WAIT_L(8); PG8_BAR; PG8_WAIT_L(0); PG8_MMA(0, 0, At, B0); PG8_BAR; PG8_SCHED;
            PG8_LDB(B1, 1, 1); PG8_STAGE(PG8_SB(1, 0), b3, voffB);
            PG8_BAR; PG8_WAIT_L(0); PG8_MMA(0, 1, At, B1); PG8_BAR;
            PG8_LDA(At, 1, 1); PG8_STAGE(PG8_SA(1, 0), a3, voffA);
            PG8_BAR; PG8_WAIT_L(0); PG8_MMA(1, 0, At, B0); PG8_BAR; PG8_SCHED;
            PG8_STAGE(PG8_SB(1, 1), b3 + hstepB, voffB);
            PG8_WAIT_V(6); PG8_BAR; PG8_MMA(1, 1, At, B1); PG8_BAR;
            }
        }
        if constexpr (ALIGN_EPI) { if (wr == 0) PG8_BAR; }
        if constexpr (!Epi::AFTER_DRAIN) E(acc, cur, wr, wc, fr, fq);
        if (!has_next) break;
#pragma unroll
        for (int a = 0; a < 2; ++a)
#pragma unroll
            for (int b = 0; b < 2; ++b)
#pragma unroll
                for (int m = 0; m < 4; ++m)
#pragma unroll
                    for (int n = 0; n < 2; ++n) acc[a][b][m][n] = (f32x4){0.f, 0.f, 0.f, 0.f};
        cur = nxt; cA = nA; cB = nB; ++ui;
        if constexpr (ALIGN_EPI) { if (wr == 1) PG8_BAR; }
    }
    PG8_WAIT_V(0);
    if constexpr (!ALIGN_EPI) { if (wr == 0) PG8_BAR; }
    PG8_BAR;
    if constexpr (Epi::AFTER_DRAIN) E.fused(acc, cur, wr, wc, fr, fq, wid, lane, lds);
#undef PG8_SA
#undef PG8_SB
#undef PG8_STAGE
#undef PG8_LDA
#undef PG8_LDB
#undef PG8_MMA
#undef PG8_WAIT_V
#undef PG8_WAIT_L
#undef PG8_BAR
#undef PG8_SCHED
}

struct EpiZ {
    static constexpr bool PERM = true; static constexpr bool HAS_MID = false, AFTER_DRAIN = false;
    bf16_t* Z; const float* rc; const float* rs; const float* bg;
    __device__ __forceinline__ void operator()(f32x4 (&acc)[2][2][4][2], const Unit& u, int wr, int wc, int fr, int fq) const {
        const int row0 = u.pm * BM + wr * 64 + fr, col0 = u.pn * BM + wc * 32 + 8 * fq;
        const bool rot = u.pn < 8; const float sc = (u.pn >= 4 && u.pn < 8) ? 0.0625f : 1.0f;
        const bool isg = u.pn >= ZO_GATE / 256;
        f32x4 bg00, bg01, bg10, bg11;
        if (isg) { const float* bp = bg + (col0 - ZO_GATE); bg00 = *(const f32x4*)bp; bg01 = *(const f32x4*)(bp + 4); bg10 = *(const f32x4*)(bp + HALF); bg11 = *(const f32x4*)(bp + HALF + 4); }
#pragma unroll
        for (int ai = 0; ai < 2; ++ai) {
            f32x4 tc0[4], tc1[4], ts0[4], ts1[4];
#pragma unroll
            for (int m = 0; m < 4; ++m) {
                if (rot && (m & 1) == 0) {
#pragma unroll
                    for (int mm = m; mm < m + 2; ++mm) {
                        const int rw = row0 + ai * HALF + mm * 16;
                        const float* pc = rc + (size_t)rw * 128 + wc * 32 + 8 * fq; const float* ps = rs + (size_t)rw * 128 + wc * 32 + 8 * fq;
                        tc0[mm] = *(const f32x4*)pc; tc1[mm] = *(const f32x4*)(pc + 4); ts0[mm] = *(const f32x4*)ps; ts1[mm] = *(const f32x4*)(ps + 4);
                    }
                }
                const int row = row0 + ai * HALF + m * 16;
                f32x4 v00 = acc[ai][0][m][0], v01 = acc[ai][0][m][1], v10 = acc[ai][1][m][0], v11 = acc[ai][1][m][1];
                if (rot) {
                    const f32x4 c0 = tc0[m], c1 = tc1[m], s0 = ts0[m], s1 = ts1[m];
                    const f32x4 a0 = v00 * c0 - v10 * s0, b0 = v00 * s0 + v10 * c0, a1 = v01 * c1 - v11 * s1, b1 = v01 * s1 + v11 * c1;
                    v00 = a0 * sc; v10 = b0 * sc; v01 = a1 * sc; v11 = b1 * sc;
                }
                if (isg) {
#pragma unroll
                    for (int i = 0; i < 4; ++i) { v00[i] = sigmoidf_(v00[i] + bg00[i]); v01[i] = sigmoidf_(v01[i] + bg01[i]); v10[i] = sigmoidf_(v10[i] + bg10[i]); v11[i] = sigmoidf_(v11[i] + bg11[i]); }
                }
                bf16_t* rowp = Z + (size_t)row * ZC + col0;
                u32x4 w0, w1; w0.x = cvtpk(v00[0], v00[1]); w0.y = cvtpk(v00[2], v00[3]); w0.z = cvtpk(v01[0], v01[1]); w0.w = cvtpk(v01[2], v01[3]);
                w1.x = cvtpk(v10[0], v10[1]); w1.y = cvtpk(v10[2], v10[3]); w1.z = cvtpk(v11[0], v11[1]); w1.w = cvtpk(v11[2], v11[3]);
                __builtin_nontemporal_store(w0, (u32x4*)rowp); __builtin_nontemporal_store(w1, (u32x4*)(rowp + HALF));
            }
        }
    }
};
#define LD4F(basep, boff) (*(const f32x4*)((const char*)(basep) + (unsigned)(boff)))
#define LD2U(basep, boff) (*(const u32x2*)((const char*)(basep) + (unsigned)(boff)))
struct EpiMerge {
    static constexpr bool PERM = true, HAS_MID = true, AFTER_DRAIN = false;
    const bf16_t* Z; bf16_t* O;
    __device__ __forceinline__ void mid(f32x4 (&acc)[2][2][4][2], const Unit& u, int wr, int wc, int fr, int fq) const {
        const int row0 = u.pm * BM + wr * 64 + fr, col0 = u.pn * BM + wc * 32 + 8 * fq;
        unsigned zo = ((unsigned)row0 * ZC + ZO_GATE + col0) * 2u; asm volatile("" : "+v"(zo));
#pragma unroll
        for (int ai = 0; ai < 2; ++ai) {
#pragma unroll
            for (int m = 0; m < 4; ++m)
#pragma unroll
                for (int bj = 0; bj < 2; ++bj) {
                    const unsigned zoff = zo + (unsigned)((ai * HALF + m * 16) * ZC + bj * HALF) * 2u;
                    const u32x4 za = *(const u32x4*)((const char*)Z + zoff), zb = *(const u32x4*)((const char*)Z + zoff + 4096u);
                    f32x4 r0, r1;
                    r0[0] = bflo(za.x) * __builtin_amdgcn_rcpf(bflo(zb.x)); r0[1] = bfhi(za.x) * __builtin_amdgcn_rcpf(bfhi(zb.x)); r0[2] = bflo(za.y) * __builtin_amdgcn_rcpf(bflo(zb.y)); r0[3] = bfhi(za.y) * __builtin_amdgcn_rcpf(bfhi(zb.y));
                    r1[0] = bflo(za.z) * __builtin_amdgcn_rcpf(bflo(zb.z)); r1[1] = bfhi(za.z) * __builtin_amdgcn_rcpf(bfhi(zb.z)); r1[2] = bflo(za.w) * __builtin_amdgcn_rcpf(bflo(zb.w)); r1[3] = bfhi(za.w) * __builtin_amdgcn_rcpf(bfhi(zb.w));
                    acc[ai][bj][m][0] *= r0; acc[ai][bj][m][1] *= r1;
                }
            asm volatile("" ::: "memory");
        }
    }
    __device__ __forceinline__ void operator()(f32x4 (&acc)[2][2][4][2], const Unit& u, int wr, int wc, int fr, int fq) const {
        const int row0 = u.pm * BM + wr * 64 + fr, col0 = u.pn * BM + wc * 32 + 8 * fq;
        unsigned zo = ((unsigned)row0 * ZC + ZO_GATE + 2048 + col0) * 2u, oo = ((unsigned)row0 * 2048 + col0) * 2u; asm volatile("" : "+v"(zo), "+v"(oo));
        u32x4 zg[2][4][2];
#pragma unroll
        for (int ai = 0; ai < 2; ++ai)
#pragma unroll
            for (int m = 0; m < 4; ++m)
#pragma unroll
                for (int bj = 0; bj < 2; ++bj) zg[ai][m][bj] = *(const u32x4*)((const char*)Z + (zo + (unsigned)((ai * HALF + m * 16) * ZC + bj * HALF) * 2u));
#pragma unroll
        for (int ai = 0; ai < 2; ++ai) {
#pragma unroll
            for (int m = 0; m < 4; ++m)
#pragma unroll
                for (int bj = 0; bj < 2; ++bj) {
                    const int rb = ai * HALF + m * 16;
                    const u32x4 zb = zg[ai][m][bj];
                    const f32x4 a0 = acc[ai][bj][m][0], a1 = acc[ai][bj][m][1];
                    u32x4 w; w.x = cvtpk(a0[0] * bflo(zb.x), a0[1] * bfhi(zb.x)); w.y = cvtpk(a0[2] * bflo(zb.y), a0[3] * bfhi(zb.y)); w.z = cvtpk(a1[0] * bflo(zb.z), a1[1] * bfhi(zb.z)); w.w = cvtpk(a1[2] * bflo(zb.w), a1[3] * bfhi(zb.w));
                    *(u32x4*)((char*)O + (oo + (unsigned)(rb * 2048 + bj * HALF) * 2u)) = w;
                }
            asm volatile("" ::: "memory");
        }
    }
};
template <int MODE> struct EpiResNorm {
    static constexpr bool PERM = false, HAS_MID = false, AFTER_DRAIN = true;
    const float* base; float* hout; const float* gate; const float* gain; const float* scsh; bf16_t* uout; float* rss; unsigned* cnt;
    __device__ __forceinline__ void fused(f32x4 (&acc)[2][2][4][2], const Unit& u, int wr, int wc, int fr, int fq, int wid, int lane, LAS unsigned char* lds) const {
        const int row0 = u.pm * BM + wr * 64 + fr, col0 = u.pn * BM + wc * 32 + 4 * fq;
        const int bat = (u.pm * BM) / SEQ;
        const float* gb = gate + (size_t)bat * 12288;
        const unsigned o0 = ((unsigned)row0 * 2048 + col0) * 4u;
        f32x4 g4[2][2];
#pragma unroll
        for (int bj = 0; bj < 2; ++bj)
#pragma unroll
            for (int n = 0; n < 2; ++n) g4[bj][n] = LD4F(gb, (col0 + bj * HALF + n * 16) * 4);
#pragma unroll
        for (int ai = 0; ai < 2; ++ai)
#pragma unroll
            for (int m = 0; m < 4; ++m) {
#pragma unroll
                for (int bj = 0; bj < 2; ++bj)
#pragma unroll
                    for (int n = 0; n < 2; ++n) {
                        const unsigned off = o0 + (unsigned)((ai * HALF + m * 16) * 2048 + bj * HALF + n * 16) * 4u;
                        const f32x4 v = LD4F(base, off) + g4[bj][n] * acc[ai][bj][m][n];
                        acc[ai][bj][m][n] = v;
                        if (MODE == 0) *(f32x4*)((char*)hout + off) = v;
                    }
                asm volatile("" : "+v"(acc[ai][0][m][0]), "+v"(acc[ai][0][m][1]), "+v"(acc[ai][1][m][0]), "+v"(acc[ai][1][m][1]));
                if (m == 3) asm volatile("" ::: "memory");
            }
        LAS float* P = (LAS float*)lds;
        LAS float* S = (LAS float*)(lds + 4096);
#pragma unroll
        for (int ai = 0; ai < 2; ++ai)
#pragma unroll
            for (int m = 0; m < 4; ++m) {
                float ss = 0.f;
#pragma unroll
                for (int bj = 0; bj < 2; ++bj)
#pragma unroll
                    for (int n = 0; n < 2; ++n) { const f32x4 v = acc[ai][bj][m][n]; ss += (v[0] * v[0] + v[1] * v[1]) + (v[2] * v[2] + v[3] * v[3]); }
                ss += __shfl_xor(ss, 16); ss += __shfl_xor(ss, 32);
                if (fq == 0) P[(ai * HALF + wr * 64 + m * 16 + fr) * 4 + wc] = ss;
            }
        asm volatile("s_waitcnt lgkmcnt(0)" ::: "memory"); __syncthreads();
        const int tid = threadIdx.x;
        float* slot = rss + (size_t)u.pm * BM + tid;
        if (tid < 256) {
            const f32x4 p4 = *(const LAS f32x4*)(P + tid * 4);
            __hip_atomic_store(slot + (size_t)u.pn * 8192, (p4[0] + p4[1]) + (p4[2] + p4[3]), __ATOMIC_RELAXED, __HIP_MEMORY_SCOPE_AGENT);
        }
        asm volatile("s_waitcnt vmcnt(0)" ::: "memory");
        __syncthreads();
        unsigned* c = cnt + 64 * u.pm;
        if (tid == 0) {
            __hip_atomic_fetch_add(c, 1u, __ATOMIC_RELAXED, __HIP_MEMORY_SCOPE_AGENT);
            unsigned sp = 0;
            while (__hip_atomic_load(c, __ATOMIC_RELAXED, __HIP_MEMORY_SCOPE_AGENT) < 8u) { __builtin_amdgcn_s_sleep(2); if (++sp > (1u << 22)) break; }
            __builtin_amdgcn_fence(__ATOMIC_ACQUIRE, "agent");
            asm volatile("s_waitcnt vmcnt(0)" ::: "memory");
        }
        __syncthreads();
        if (tid < 256) {
            float tot = 0.f;
#pragma unroll
            for (int t = 0; t < 8; ++t) tot += __hip_atomic_load(slot + (size_t)t * 8192, __ATOMIC_RELAXED, __HIP_MEMORY_SCOPE_AGENT);
            S[tid] = rsqrtf(tot * (1.0f / 2048.0f) + NORM_EPS);
        }
        asm volatile("s_waitcnt lgkmcnt(0)" ::: "memory"); __syncthreads();
        const float* mb = scsh + (size_t)bat * 12288;
        unsigned u0 = ((unsigned)row0 * 2048 + col0) * 2u, o1 = o0; asm volatile("" : "+v"(u0), "+v"(o1));
#pragma unroll
        for (int ai = 0; ai < 2; ++ai)
#pragma unroll
            for (int m = 0; m < 4; ++m) {
                const int rb = ai * HALF + m * 16;
                const float rstd = S[rb + wr * 64 + fr];
#pragma unroll
                for (int bj = 0; bj < 2; ++bj)
#pragma unroll
                    for (int n = 0; n < 2; ++n) {
                        const int cb = bj * HALF + n * 16;
                        const f32x4 gn = LD4F(gain, (col0 + cb) * 4);
                        f32x4 o = acc[ai][bj][m][n] * rstd * gn;
                        if (MODE == 0) {
                            const f32x4 sc = LD4F(mb, (2048 + col0 + cb) * 4), sh = LD4F(mb, (col0 + cb) * 4);
                            o = o * (sc + 1.0f) + sh;
                            u32x2 w; w.x = cvtpk(o[0], o[1]); w.y = cvtpk(o[2], o[3]);
                            *(u32x2*)((char*)uout + (u0 + (unsigned)(rb * 2048 + cb) * 2u)) = w;
                        } else *(f32x4*)((char*)hout + (o1 + (unsigned)(rb * 2048 + cb) * 4u)) = o;
                    }
                asm volatile("" ::: "memory");
            }
    }
};
struct EpiNull {
    static constexpr bool PERM = false, HAS_MID = false, AFTER_DRAIN = false;
    __device__ __forceinline__ void operator()(f32x4 (&acc)[2][2][4][2], const Unit& u, int wr, int wc, int fr, int fq) const {
#pragma unroll
        for (int ai = 0; ai < 2; ++ai)
#pragma unroll
            for (int m = 0; m < 4; ++m) asm volatile("" :: "v"(acc[ai][0][m][0]), "v"(acc[ai][0][m][1]), "v"(acc[ai][1][m][0]), "v"(acc[ai][1][m][1]));
    }
};
template <int LDC, int COFF> struct EpiPlain {
    static constexpr bool PERM = true, HAS_MID = false, AFTER_DRAIN = false;
    bf16_t* O;
    __device__ __forceinline__ void operator()(f32x4 (&acc)[2][2][4][2], const Unit& u, int wr, int wc, int fr, int fq) const {
        const int row0 = u.pm * BM + wr * 64 + fr, col0 = COFF + u.pn * BM + wc * 32 + 8 * fq;
        const unsigned o0 = ((unsigned)row0 * LDC + col0) * 2u;
#pragma unroll
        for (int ai = 0; ai < 2; ++ai)
#pragma unroll
            for (int m = 0; m < 4; ++m)
#pragma unroll
                for (int bj = 0; bj < 2; ++bj) {
                    const f32x4 v0 = acc[ai][bj][m][0], v1 = acc[ai][bj][m][1];
                    u32x4 w; w.x = cvtpk(v0[0], v0[1]); w.y = cvtpk(v0[2], v0[3]); w.z = cvtpk(v1[0], v1[1]); w.w = cvtpk(v1[2], v1[3]);
                    *(u32x4*)((char*)O + (o0 + (unsigned)((ai * HALF + m * 16) * LDC + bj * HALF) * 2u)) = w;
                }
    }
};
struct EpiSwiglu {
    static constexpr bool PERM = true; static constexpr bool HAS_MID = false, AFTER_DRAIN = false;
    bf16_t* H;
    __device__ __forceinline__ void operator()(f32x4 (&acc)[2][2][4][2], const Unit& u, int wr, int wc, int fr, int fq) const {
        const int row0 = u.pm * BM + wr * 64 + fr, col0 = u.pn * HALF + wc * 32 + 8 * fq;
#pragma unroll
        for (int ai = 0; ai < 2; ++ai)
#pragma unroll
            for (int m = 0; m < 4; ++m) {
                const f32x4 g0 = acc[ai][0][m][0], g1 = acc[ai][0][m][1], u0 = acc[ai][1][m][0], u1 = acc[ai][1][m][1];
                f32x4 h0, h1;
#pragma unroll
                for (int i = 0; i < 4; ++i) { h0[i] = siluf_(g0[i]) * u0[i]; h1[i] = siluf_(g1[i]) * u1[i]; }
                u32x4 w; w.x = cvtpk(h0[0], h0[1]); w.y = cvtpk(h0[2], h0[3]); w.z = cvtpk(h1[0], h1[1]); w.w = cvtpk(h1[2], h1[3]);
                __builtin_nontemporal_store(w, (u32x4*)(H + (size_t)(row0 + ai * HALF + m * 16) * FFH + col0));
            }
    }
};
}

struct Frame {
    LAS unsigned char* lds; volatile LAS unsigned* MISC; unsigned* ctl;
    int tid, lane, wave, vcu, G;
    const float* const* in; float* out; unsigned char* ws;
};
#define IN_F(k) ((const float*)F.in[k])

__device__ __forceinline__ void p0_ada(Frame& F, float wscale) {
    const float* c = IN_F(1); const float* w = IN_F(3); const float* bA = IN_F(4);
    float* mod = (float*)(F.ctl + CW_MOD);
    const int ai_ = ((F.vcu & 31) < 24) ? (F.vcu >> 5) * 24 + (F.vcu & 31) : 192;
    for (int item = ai_; item < 48 * 4; item += 192) {
        const int cg = item % 48, ksg = item / 48, ks = ksg * 8 + F.wave, col = cg * 256 + F.lane * 4;
        const float s0 = siluf_(c[ks * 64 + F.lane]), s1 = siluf_(c[2048 + ks * 64 + F.lane]);
        f32x4 a0 = {0.f, 0.f, 0.f, 0.f}, a1 = {0.f, 0.f, 0.f, 0.f};
        const float* wp = w + (size_t)(ks * 64) * 12288 + col;
#pragma unroll 16
        for (int kk = 0; kk < 64; ++kk) {
            const f32x4 wv = __builtin_nontemporal_load((const f32x4*)(wp + (size_t)kk * 12288));
            const float c0 = __uint_as_float(__builtin_amdgcn_readlane(__float_as_uint(s0), kk)), c1 = __uint_as_float(__builtin_amdgcn_readlane(__float_as_uint(s1), kk));
            a0 += wv * c0; a1 += wv * c1;
        }
        LAS float* red = (LAS float*)F.lds;
#pragma unroll
        for (int i = 0; i < 4; ++i) { red[(F.wave * 8 + i) * 64 + F.lane] = a0[i]; red[(F.wave * 8 + 4 + i) * 64 + F.lane] = a1[i]; }
        __syncthreads();
        {
            float sum = 0.f;
#pragma unroll
            for (int ww = 0; ww < 8; ++ww) sum += red[(ww * 8 + F.wave) * 64 + F.lane];
            const int i = F.wave & 3, bt = F.wave >> 2, cc = cg * 256 + F.lane * 4 + i;
            if (ksg == 0) sum += bA[cc];
            atomicAdd(mod + bt * 12288 + cc, sum * wscale);
        }
        asm volatile("s_waitcnt vmcnt(0)" ::: "memory");
        __syncthreads();
        if (F.tid == 0) __hip_atomic_fetch_add(F.ctl + CW_ADA, 1u, __ATOMIC_RELAXED, __HIP_MEMORY_SCOPE_AGENT);
    }
}
__device__ __forceinline__ void p0_wait_ada(Frame& F, unsigned want) {
    unsigned sp = 0;
    while (__hip_atomic_load(F.ctl + CW_ADA, __ATOMIC_RELAXED, __HIP_MEMORY_SCOPE_AGENT) < want) { __builtin_amdgcn_s_sleep(4); if (++sp > (1u << 22)) break; }
    __builtin_amdgcn_fence(__ATOMIC_ACQUIRE, "agent");
    asm volatile("s_waitcnt vmcnt(0)" ::: "memory");
}
constexpr int TI0 = 32 * 183, TI1 = 16 * 32, TI2 = 16 * 32, TI3 = 32 * 32, TI4 = 32 * 176, TI5 = 88 * 32;
constexpr int F1G = 2048;
constexpr int TR_WIN_LO = 0, TR_WIN_HI = TI0, TR_MO_LO = TI0, TR_MO_HI = TI0 + TI1 + TI2 + TI3, TR_F1_LO = TR_MO_HI, TR_F1_HI = TR_MO_HI + TI4, TR_F2_LO = TR_F1_HI, TR_F2_HI = TR_F1_HI + TI5;
struct TrItem { const float* src; int Ns, k0, n0; bf16_t* dst; int dpitch, drow, dk0; };
__device__ __forceinline__ TrItem tr_decode(Frame& F, int it) {
    TrItem t; int r = it;
    if (r < TI0) { const int kb = r / 183, nb = r % 183, n0 = nb * 64; t = TrItem{IN_F(8), IN_COLS, kb * 64, n0, (bf16_t*)(F.ws + WS_WIN), 2048, n0 < 7616 ? n0 : n0 + 64, kb * 64}; return t; } r -= TI0;
    if (r < TI1) { const int kb = r / 32, nb = r % 32; t = TrItem{IN_F(21), 2048, kb * 64, nb * 64, (bf16_t*)(F.ws + WS_WMRG), 2048, nb * 64, kb * 64}; return t; } r -= TI1;
    if (r < TI2) { const int kb = r / 32, nb = r % 32; t = TrItem{IN_F(22), 2048, kb * 64, nb * 64, (bf16_t*)(F.ws + WS_WMRG), 2048, nb * 64, 1024 + kb * 64}; return t; } r -= TI2;
    if (r < TI3) { const int kb = r / 32, nb = r % 32; t = TrItem{IN_F(23), 2048, kb * 64, nb * 64, (bf16_t*)(F.ws + WS_WO), 2048, nb * 64, kb * 64}; return t; } r -= TI3;
    if (r < TI4) { const int kb = r / 176, nb = r % 176, n0 = nb * 64, half = n0 / FFH, jj = n0 % FFH;
        t = TrItem{IN_F(24), FF2, kb * 64, n0, (bf16_t*)(F.ws + WS_WF1), 2048, (jj / 128) * 256 + half * 128 + (jj % 128), kb * 64}; return t; } r -= TI4;
    { const int kb = r / 32, nb = r % 32; t = TrItem{IN_F(25), 2048, kb * 64, nb * 64, (bf16_t*)(F.ws + WS_WF2), FFH, nb * 64, kb * 64}; return t; }
}
__device__ __forceinline__ void tr_load(const TrItem& t, f32x4 (&v)[16], int lane) {
#pragma unroll
    for (int i = 0; i < 16; ++i) v[i] = __builtin_nontemporal_load((const f32x4*)(t.src + (size_t)(t.k0 + 4 * i + (lane >> 4)) * t.Ns + t.n0 + (lane & 15) * 4));
}
__device__ __forceinline__ void tr_finish(const TrItem& t, const f32x4 (&v)[16], LAS float* scr, int lane) {
#pragma unroll
    for (int i = 0; i < 16; ++i) { LAS float* sp = scr + (4 * i + (lane >> 4)) * 65 + (lane & 15) * 4; sp[0] = v[i][0]; sp[1] = v[i][1]; sp[2] = v[i][2]; sp[3] = v[i][3]; }
    LDS_WAIT(); asm volatile("" ::: "memory");
    const int c = lane >> 3;
#pragma unroll
    for (int j = 0; j < 8; ++j) {
        const int n = (lane & 7) + 8 * j; const LAS float* sp = scr + (8 * c) * 65 + n;
        u32x4 o; o.x = cvtpk(sp[0], sp[65]); o.y = cvtpk(sp[2 * 65], sp[3 * 65]); o.z = cvtpk(sp[4 * 65], sp[5 * 65]); o.w = cvtpk(sp[6 * 65], sp[7 * 65]);
        *(u32x4*)(t.dst + (size_t)(t.drow + n) * t.dpitch + t.dk0 + 8 * c) = o;
    }
    LDS_WAIT(); asm volatile("" ::: "memory");
}
__device__ __forceinline__ void p0_transposes(Frame& F, int lo, int n, int gw, int NGW) {
    LAS float* scr = (LAS float*)(F.lds + F.wave * 16896);
    f32x4 va[16], vb[16];
    int ia = gw;
    if (ia >= n) return;
    TrItem ta = tr_decode(F, lo + ia), tb = ta;
    tr_load(ta, va, F.lane);
    for (;;) {
        const int ib = ia + NGW;
        if (ib < n) { tb = tr_decode(F, lo + ib); tr_load(tb, vb, F.lane); }
        tr_finish(ta, va, scr, F.lane);
        if (ib >= n) break;
        ia = ib + NGW;
        if (ia < n) { ta = tr_decode(F, lo + ia); tr_load(ta, va, F.lane); }
        tr_finish(tb, vb, scr, F.lane);
        if (ia >= n) break;
    }
}
__device__ __forceinline__ void p0_small(Frame& F, int wi) {
    const int gt = wi * NTHR + F.tid, NT = 64 * NTHR;
    bf16_t* lt = (bf16_t*)(F.ws + WS_LORA);
    for (int it = gt; it < 12288 + 12288 + 32768; it += NT) {
        const float* src; int kc, col, KK; bf16_t* dst;
        if (it < 12288) { src = IN_F(12); kc = it >> 10; col = it & 1023; KK = 96; dst = lt; }
        else if (it < 24576) { src = IN_F(14); kc = (it - 12288) >> 10; col = it & 1023; KK = 96; dst = lt + 1024 * 96; }
        else { src = IN_F(15); kc = (it - 24576) >> 10; col = it & 1023; KK = 256; dst = lt + 2 * 1024 * 96; }
        float v[8];
#pragma unroll
        for (int e = 0; e < 8; ++e) v[e] = src[(size_t)(kc * 8 + e) * 1024 + col];
        u32x4 o; o.x = cvtpk(v[0], v[1]); o.y = cvtpk(v[2], v[3]); o.z = cvtpk(v[4], v[5]); o.w = cvtpk(v[6], v[7]);
        *(u32x4*)(dst + (size_t)col * KK + kc * 8) = o;
    }
    for (int it = gt; it < 16384; it += NT) ((u32x4*)((bf16_t*)(F.ws + WS_WIN) + (size_t)7616 * 2048))[it] = (u32x4){0u, 0u, 0u, 0u};
    const int* pos = (const int*)F.in[2];
    float* rc = (float*)(F.ws + WS_ROPE); float* rs = rc + (size_t)M * 128;
    for (int idx = gt; idx < M * 128; idx += NT) {
        const int tok = idx >> 7, j = idx & 127;
        const double y = -(double)j * (9.210340371976184 / 128.0);
        const double nn = __builtin_rint(y * 1.4426950408889634), r = __builtin_fma(-nn, 6.93147180369123816490e-01, y) - nn * 1.90821492927058770002e-10;
        double e = 1.0 / 87178291200.0;
        e = e * r + 1.0 / 6227020800.0; e = e * r + 1.0 / 479001600.0; e = e * r + 1.0 / 39916800.0; e = e * r + 1.0 / 3628800.0; e = e * r + 1.0 / 362880.0; e = e * r + 1.0 / 40320.0;
        e = e * r + 1.0 / 5040.0; e = e * r + 1.0 / 720.0; e = e * r + 1.0 / 120.0; e = e * r + 1.0 / 24.0; e = e * r + 1.0 / 6.0; e = e * r + 0.5; e = e * r + 1.0; e = e * r + 1.0;
        const long long sh = (long long)nn; const double sc = __builtin_bit_cast(double, (unsigned long long)(1023 + sh) << 52);
        const float inv = (float)(e * sc);
        const float ang = (float)pos[tok] * inv;
        const double a = (double)ang;
        const double qn = __builtin_rint(a * 6.36619772367581382433e-01);
        double t = __builtin_fma(-qn, 1.57079632673412561417e+00, a); t = __builtin_fma(-qn, 6.07710050650619224932e-11, t);
        const double z = t * t;
        const double sn = t + t * z * (-1.66666666666666324348e-01 + z * (8.33333333332248946124e-03 + z * (-1.98412698298579493134e-04 + z * (2.75573137070700676789e-06 + z * (-2.50507602534068634195e-08 + z * 1.58969099521155010221e-10)))));
        const double cs = 1.0 - 0.5 * z + z * z * (4.16666666666666019037e-02 + z * (-1.38888888888741095749e-03 + z * (2.48015872894767294178e-05 + z * (-2.75573143513906633035e-07 + z * (2.08757232129817482790e-09 + z * -1.13596475577881948265e-11)))));
        const int qd = (int)((long long)qn & 3);
        const double so = (qd == 0) ? sn : (qd == 1) ? cs : (qd == 2) ? -sn : -cs;
        const double co = (qd == 0) ? cs : (qd == 1) ? -sn : (qd == 2) ? -cs : sn;
        rc[idx] = (float)co; rs[idx] = (float)so;
    }
}
__device__ __forceinline__ void norm_mod_rows(Frame& F, const float* src, const float* gain, int sc_off, int sh_off, bf16_t* dst) {
    const float* mod = (const float*)(F.ctl + CW_MOD);
    const int gw = F.vcu * NWAVES + F.wave, NGW = F.G * NWAVES;
    f32x4 v[8], nx[8], nx2[8], cg[8], ch[8];
    if (gw < M) {
#pragma unroll
        for (int j = 0; j < 8; ++j) nx[j] = __builtin_nontemporal_load((const f32x4*)(src + (size_t)gw * D) + F.lane + 64 * j);
    }
    if (gw + NGW < M) {
#pragma unroll
        for (int j = 0; j < 8; ++j) nx2[j] = __builtin_nontemporal_load((const f32x4*)(src + (size_t)(gw + NGW) * D) + F.lane + 64 * j);
    }
    int cur_b = -1;
    for (int row = gw; row < M; row += NGW) {
        float ss = 0.f;
#pragma unroll
        for (int j = 0; j < 8; ++j) { v[j] = nx[j]; ss += (v[j][0] * v[j][0] + v[j][1] * v[j][1]) + (v[j][2] * v[j][2] + v[j][3] * v[j][3]); }
#pragma unroll
        for (int j = 0; j < 8; ++j) nx[j] = nx2[j];
        if (row + 2 * NGW < M) {
#pragma unroll
            for (int j = 0; j < 8; ++j) nx2[j] = __builtin_nontemporal_load((const f32x4*)(src + (size_t)(row + 2 * NGW) * D) + F.lane + 64 * j);
        }
        const int bt = row / SEQ;
        if (bt != cur_b) {
            cur_b = bt; const float* mb = mod + (size_t)bt * 12288;
#pragma unroll
            for (int j = 0; j < 8; ++j) { const int col = 256 * j + 4 * F.lane; cg[j] = *(const f32x4*)(gain + col) * (*(const f32x4*)(mb + sc_off + col) + 1.0f); ch[j] = *(const f32x4*)(mb + sh_off + col); }
        }
        const float rstd = rsqrtf(wave_sum(ss) * (1.0f / D) + NORM_EPS);
#pragma unroll
        for (int j = 0; j < 8; ++j) {
            const f32x4 o = v[j] * rstd * cg[j] + ch[j];
            u32x2 w; w.x = cvtpk(o[0], o[1]); w.y = cvtpk(o[2], o[3]);
            *(u32x2*)(dst + (size_t)row * D + 256 * j + 4 * F.lane) = w;
        }
    }
}
__device__ __forceinline__ void final_norm_rows(Frame& F, float* io, const float* gain) {
    const int gw = F.vcu * NWAVES + F.wave, NGW = F.G * NWAVES;
    for (int row = gw; row < M; row += NGW) {
        f32x4* xr = (f32x4*)(io + (size_t)row * D) + F.lane;
        f32x4 v[8]; float ss = 0.f;
#pragma unroll
        for (int j = 0; j < 8; ++j) { v[j] = xr[64 * j]; ss += (v[j][0] * v[j][0] + v[j][1] * v[j][1]) + (v[j][2] * v[j][2] + v[j][3] * v[j][3]); }
        const float rstd = rsqrtf(wave_sum(ss) * (1.0f / D) + NORM_EPS);
#pragma unroll
        for (int j = 0; j < 8; ++j) { const f32x4 gn = *(const f32x4*)(gain + 256 * j + 4 * F.lane); xr[64 * j] = v[j] * rstd * gn; }
    }
}

constexpr int RK_PITCH = 528, RV_PITCH = 544;
__device__ __forceinline__ float ret_lg2(int h) { return log2f(1.0f - exp2f(-5.0f - (float)h)); }
__device__ __forceinline__ u32x4 scale8(u32x4 v, float s) {
    u32x4 o; o.x = cvtpk(bflo(v.x) * s, bfhi(v.x) * s); o.y = cvtpk(bflo(v.y) * s, bfhi(v.y) * s); o.z = cvtpk(bflo(v.z) * s, bfhi(v.z) * s); o.w = cvtpk(bflo(v.w) * s, bfhi(v.w) * s); return o;
}
__device__ __forceinline__ void ret_kv_unit(Frame& F, int unit) {
    const int n = unit & 31, bh = unit >> 5, h = bh & 3, b = bh >> 2;
    const bf16_t* Z = (const bf16_t*)(F.ws + WS_Z);
    const size_t row0 = (size_t)b * SEQ + (size_t)n * 128;
    const float lg2 = ret_lg2(h);
    LAS unsigned char* Kt = F.lds; LAS unsigned char* Vt = F.lds + 64 * RV_PITCH;
    const int w = F.wave, lane = F.lane, li = lane & 15, g = lane >> 4, q = li >> 2, p = li & 3;
    f32x4 acc[2][16];
#pragma unroll
    for (int a = 0; a < 2; ++a)
#pragma unroll
        for (int d = 0; d < 16; ++d) acc[a][d] = (f32x4){0.f, 0.f, 0.f, 0.f};
    for (int hh = 0; hh < 2; ++hh) {
#pragma unroll
        for (int i = 0; i < 4; ++i) {
            const int e = F.tid + NTHR * i, row = e >> 5, ch = e & 31;
            const bf16_t* zr = Z + (row0 + 64 * hh + row) * ZC + 256 * h + 8 * ch;
            const u32x4 kv = *(const u32x4*)(zr + ZO_K), vv = *(const u32x4*)(zr + ZO_V);
            const float zeta = exp2f((float)(127 - (64 * hh + row)) * lg2);
            *(LAS u32x4*)(Kt + row * RV_PITCH + ch * 16) = scale8(kv, zeta);
            *(LAS u32x4*)(Vt + row * RV_PITCH + ch * 16) = vv;
        }
        __syncthreads();
#pragma unroll
        for (int ks = 0; ks < 2; ++ks) {
            const LAS unsigned char* ka = Kt + (32 * ks + 8 * g + q) * RV_PITCH + (32 * w + 4 * p) * 2;
            const s16x4 a0l = trread(ka), a0h = trread(ka + 4 * RV_PITCH), a1l = trread(ka + 32), a1h = trread(ka + 32 + 4 * RV_PITCH);
            const bf16x8 a0 = PK8(a0l, a0h), a1 = PK8(a1l, a1h);
            const LAS unsigned char* vb = Vt + (32 * ks + 8 * g + q) * RV_PITCH + (4 * p) * 2;
#pragma unroll
            for (int d = 0; d < 16; ++d) {
                const s16x4 bl = trread(vb + d * 32), bhh = trread(vb + d * 32 + 4 * RV_PITCH);
                const bf16x8 bb = PK8(bl, bhh);
                acc[0][d] = __builtin_amdgcn_mfma_f32_16x16x32_bf16(a0, bb, acc[0][d], 0, 0, 0);
                acc[1][d] = __builtin_amdgcn_mfma_f32_16x16x32_bf16(a1, bb, acc[1][d], 0, 0, 0);
            }
        }
        __syncthreads();
    }
    bf16_t* SF = (bf16_t*)(F.ws + WS_SF) + (size_t)unit * 65536;
#pragma unroll
    for (int d = 0; d < 16; ++d) {
        u32x4 o; o.x = cvtpk(acc[0][d][0], acc[0][d][1]); o.y = cvtpk(acc[0][d][2], acc[0][d][3]); o.z = cvtpk(acc[1][d][0], acc[1][d][1]); o.w = cvtpk(acc[1][d][2], acc[1][d][3]);
        *(u32x4*)(SF + ((size_t)(w * 16 + d) * 64 + lane) * 8) = o;
    }
}
__device__ __forceinline__ void ret_scan(Frame& F, int nblk, int wi) {
    for (int gt = wi * NTHR + F.tid; gt < 65536; gt += nblk * NTHR) {
    const int bh = gt >> 13, off = gt & 8191, h = bh & 3;
    const float cd = exp2f(128.0f * ret_lg2(h));
    u32x4* p = (u32x4*)(F.ws + WS_SF) + (size_t)bh * 32 * 8192 + off;
    float s[8];
#pragma unroll
    for (int e = 0; e < 8; ++e) s[e] = 0.f;
#pragma unroll 16
    for (int n = 0; n < 32; ++n) {
        const u32x4 kv = p[(size_t)n * 8192];
        u32x4 o; o.x = cvtpk(s[0], s[1]); o.y = cvtpk(s[2], s[3]); o.z = cvtpk(s[4], s[5]); o.w = cvtpk(s[6], s[7]);
        p[(size_t)n * 8192] = o;
        s[0] = s[0] * cd + bflo(kv.x); s[1] = s[1] * cd + bfhi(kv.x); s[2] = s[2] * cd + bflo(kv.y); s[3] = s[3] * cd + bfhi(kv.y);
        s[4] = s[4] * cd + bflo(kv.z); s[5] = s[5] * cd + bfhi(kv.z); s[6] = s[6] * cd + bflo(kv.w); s[7] = s[7] * cd + bfhi(kv.w);
    }
    }
}
__device__ __forceinline__ void ret_out_unit(Frame& F, int unit) {
    const int n = unit & 31, bh = unit >> 5, h = bh & 3, b = bh >> 2;
    const bf16_t* Z = (const bf16_t*)(F.ws + WS_Z);
    const size_t row0 = (size_t)b * SEQ + (size_t)n * 128;
    const float lg2 = ret_lg2(h);
    LAS unsigned char* Kt = F.lds; LAS unsigned char* Vt = F.lds + 128 * RK_PITCH;
    const int w = F.wave, lane = F.lane, li = lane & 15, g = lane >> 4, q = li >> 2, p = li & 3;
    const int c0 = 16 * w; const size_t myrow = row0 + c0 + li;
    const bf16_t* zq = Z + myrow * ZC + ZO_Q + 256 * h;
    bf16x8 qn[8];
    f32x4 acc[16];
#pragma unroll
    for (int d = 0; d < 16; ++d) acc[d] = (f32x4){0.f, 0.f, 0.f, 0.f};
    if (n > 0) {
        const u32x4* SFv = (const u32x4*)((const bf16_t*)(F.ws + WS_SF) + (size_t)unit * 65536);
        u32x4 stg[16];
#pragma unroll
        for (int i = 0; i < 16; ++i) stg[i] = SFv[F.tid + NTHR * i];
        bf16x8 qp[8];
#pragma unroll
        for (int ks = 0; ks < 8; ++ks) {
            const s16x4 lo = *(const s16x4*)(zq + 32 * ks + 4 * g), hi = *(const s16x4*)(zq + 32 * ks + 16 + 4 * g);
            qp[ks] = PK8(lo, hi);
        }
#pragma unroll
        for (int i = 0; i < 16; ++i) *(LAS u32x4*)(F.lds + (F.tid + NTHR * i) * 16) = stg[i];
        __syncthreads();
#pragma unroll
        for (int d = 0; d < 16; ++d)
#pragma unroll
            for (int ks = 0; ks < 8; ++ks) {
                const bf16x8 a = *(const LAS bf16x8*)(F.lds + ((ks * 16 + d) * 64 + lane) * 16);
                acc[d] = __builtin_amdgcn_mfma_f32_16x16x32_bf16(a, qp[ks], acc[d], 0, 0, 0);
            }
        const float xi = exp2f((float)(c0 + li + 1) * lg2);
#pragma unroll
        for (int d = 0; d < 16; ++d) acc[d] *= xi;
        __syncthreads();
    }
#pragma unroll
    for (int i = 0; i < 8; ++i) {
        const int e = F.tid + NTHR * i, row = e >> 5, ch = e & 31;
        const bf16_t* zr = Z + (row0 + row) * ZC + 256 * h + 8 * ch;
        *(LAS u32x4*)(Kt + row * RK_PITCH + ch * 16) = *(const u32x4*)(zr + ZO_K);
        *(LAS u32x4*)(Vt + row * RV_PITCH + ch * 16) = *(const u32x4*)(zr + ZO_V);
    }
#pragma unroll
    for (int ks = 0; ks < 8; ++ks) qn[ks] = *(const bf16x8*)(zq + 32 * ks + 8 * g);
    __syncthreads();
    u32x4 gst[8];
#pragma unroll
    for (int i = 0; i < 8; ++i) gst[i] = *(const u32x4*)(Z + (row0 + c0 + 2 * i + (lane >> 5)) * ZC + ZO_G + 256 * h + (lane & 31) * 8);
    for (int st2 = 0; 2 * st2 <= w; ++st2) {
        f32x4 X0 = {0.f, 0.f, 0.f, 0.f}, X1 = {0.f, 0.f, 0.f, 0.f};
        const bool has1 = (2 * st2 + 1 <= w);
        const LAS unsigned char* kb = Kt + (32 * st2 + li) * RK_PITCH + (8 * g) * 2;
#pragma unroll
        for (int ks = 0; ks < 8; ++ks) X0 = __builtin_amdgcn_mfma_f32_16x16x32_bf16(*(const LAS bf16x8*)(kb + ks * 64), qn[ks], X0, 0, 0, 0);
        if (has1) {
#pragma unroll
            for (int ks = 0; ks < 8; ++ks) X1 = __builtin_amdgcn_mfma_f32_16x16x32_bf16(*(const LAS bf16x8*)(kb + 16 * RK_PITCH + ks * 64), qn[ks], X1, 0, 0, 0);
        }
        const int cl = c0 + li;
#pragma unroll
        for (int i = 0; i < 4; ++i) {
            const int d0 = cl - (32 * st2 + 4 * g + i), d1 = d0 - 16;
            X0[i] = d0 >= 0 ? X0[i] * exp2f((float)d0 * lg2) : 0.f;
            X1[i] = (has1 && d1 >= 0) ? X1[i] * exp2f((float)d1 * lg2) : 0.f;
        }
        u32x4 pbu; pbu.x = cvtpk(X0[0], X0[1]); pbu.y = cvtpk(X0[2], X0[3]); pbu.z = cvtpk(X1[0], X1[1]); pbu.w = cvtpk(X1[2], X1[3]);
        const bf16x8 pb = __builtin_bit_cast(bf16x8, pbu);
        const LAS unsigned char* vb = Vt + (32 * st2 + 4 * g + q) * RV_PITCH + (4 * p) * 2;
#pragma unroll
        for (int d = 0; d < 16; ++d) {
            const s16x4 lo = trread(vb + d * 32), hi = trread(vb + d * 32 + 16 * RV_PITCH);
            const bf16x8 a = PK8(lo, hi);
            acc[d] = __builtin_amdgcn_mfma_f32_16x16x32_bf16(a, pb, acc[d], 0, 0, 0);
        }
    }
    float s = 0.f;
#pragma unroll
    for (int d = 0; d < 16; ++d) s += (acc[d][0] + acc[d][1]) + (acc[d][2] + acc[d][3]);
    s += __shfl_xor(s, 16); s += __shfl_xor(s, 32);
    const float mean = s * (1.0f / 256.0f);
    float qv = 0.f;
#pragma unroll
    for (int d = 0; d < 16; ++d) { const f32x4 dd = acc[d] - mean; qv += (dd[0] * dd[0] + dd[1] * dd[1]) + (dd[2] * dd[2] + dd[3] * dd[3]); }
    qv += __shfl_xor(qv, 16); qv += __shfl_xor(qv, 32);
    const float rstd = rsqrtf(qv * (1.0f / 256.0f) + 1e-5f);
    __syncthreads();
    {
        constexpr int GP = 528;
        LAS unsigned char* wl = F.lds + w * 17600;
#pragma unroll
        for (int i = 0; i < 8; ++i) *(LAS u32x4*)(wl + (2 * i + (lane >> 5)) * GP + (lane & 31) * 16) = gst[i];
        asm volatile("s_waitcnt lgkmcnt(0)" ::: "memory");
#pragma unroll
        for (int d = 0; d < 16; ++d) {
            LAS u32x2* gp = (LAS u32x2*)(wl + li * GP + (16 * d + 4 * g) * 2);
            const u32x2 gz = *gp;
            const f32x4 o = (acc[d] - mean) * rstd;
            u32x2 wv; wv.x = cvtpk(o[0] * siluf_(bflo(gz.x)), o[1] * siluf_(bfhi(gz.x))); wv.y = cvtpk(o[2] * siluf_(bflo(gz.y)), o[3] * siluf_(bfhi(gz.y)));
            *gp = wv;
        }
        asm volatile("s_waitcnt lgkmcnt(0)" ::: "memory");
        bf16_t* Y = (bf16_t*)(F.ws + WS_Y);
#pragma unroll
        for (int i = 0; i < 8; ++i) {
            const int r = 2 * i + (lane >> 5);
            *(u32x4*)(Y + (row0 + c0 + r) * 2048 + 256 * h + (lane & 31) * 8) = *(const LAS u32x4*)(wl + r * GP + (lane & 31) * 16);
        }
    }
    __syncthreads();
}

template <int ACT> __device__ __forceinline__ bf16x8 shift_frag(const bf16_t* Z, size_t row, bool has_prev, int zcol, const float* mu) {
    const u32x4 cu = *(const u32x4*)(Z + row * ZC + zcol);
    u32x4 pv = {0u, 0u, 0u, 0u}; if (has_prev) pv = *(const u32x4*)(Z + (row - 1) * ZC + zcol);
    const f32x4 m0 = *(const f32x4*)(mu + (zcol - ZO_RW)), m1 = *(const f32x4*)(mu + (zcol - ZO_RW) + 4);
    float v[8]; const unsigned cw[4] = {cu.x, cu.y, cu.z, cu.w}, pw[4] = {pv.x, pv.y, pv.z, pv.w};
#pragma unroll
    for (int e = 0; e < 4; ++e) {
        const float c0 = bflo(cw[e]), c1 = bfhi(cw[e]), p0 = bflo(pw[e]), p1 = bfhi(pw[e]);
        const float mm0 = (e < 2) ? m0[2 * e] : m1[2 * e - 4], mm1 = (e < 2) ? m0[2 * e + 1] : m1[2 * e - 3];
        v[2 * e] = c0 + (p0 - c0) * mm0; v[2 * e + 1] = c1 + (p1 - c1) * mm1;
    }
#pragma unroll
    for (int e = 0; e < 8; ++e) { if (ACT == 1) v[e] = 2.0f * __builtin_amdgcn_rcpf(1.0f + __expf(-2.0f * v[e])) - 1.0f; if (ACT == 2) v[e] = sigmoidf_(v[e]); }
    u32x4 o; o.x = cvtpk(v[0], v[1]); o.y = cvtpk(v[2], v[3]); o.z = cvtpk(v[4], v[5]); o.w = cvtpk(v[6], v[7]);
    return __builtin_bit_cast(bf16x8, o);
}
__device__ __forceinline__ void shift8(const bf16_t* Z, size_t row, bool has_prev, int zcol, const float* mu, float (&v)[8]) {
    const u32x4 cu = *(const u32x4*)(Z + row * ZC + zcol);
    u32x4 pv = {0u, 0u, 0u, 0u}; if (has_prev) pv = *(const u32x4*)(Z + (row - 1) * ZC + zcol);
    const f32x4 m0 = *(const f32x4*)(mu + (zcol - ZO_RW)), m1 = *(const f32x4*)(mu + (zcol - ZO_RW) + 4);
    const unsigned cw[4] = {cu.x, cu.y, cu.z, cu.w}, pw[4] = {pv.x, pv.y, pv.z, pv.w};
#pragma unroll
    for (int e = 0; e < 4; ++e) {
        const float c0 = bflo(cw[e]), c1 = bfhi(cw[e]), p0 = bflo(pw[e]), p1 = bfhi(pw[e]);
        const float mm0 = (e < 2) ? m0[2 * e] : m1[2 * e - 4], mm1 = (e < 2) ? m0[2 * e + 1] : m1[2 * e - 3];
        v[2 * e] = c0 + (p0 - c0) * mm0; v[2 * e + 1] = c1 + (p1 - c1) * mm1;
    }
}

constexpr size_t RWC_QTF = 0, RWC_NTF = 16 * MiB, RWC_RWF = 32 * MiB, RWC_Y0F = 48 * MiB;
constexpr size_t WS_XF = WS_U;
constexpr size_t WS_P63 = WS_U + 16 * MiB;
constexpr size_t WS_BON = WS_U + 17 * MiB;
constexpr size_t WS_SG = WS_U + 18 * MiB;
constexpr int TP = 144;
constexpr int T_AT = 0, T_BT = 9216, T_KT = 18432, T_RT = 27648, T_VV = 36864, T_AAB = 46080, T_AAK = 55296, T_RB = 64512, T_RK = 73728, T_WW = 82944, T_U0 = 92160;
constexpr int F_PD = 101376, F_PI = 117760, F_SEG = 134144, F_P63 = 136192, F_DIAG = 136448, F_DT = F_DIAG + 4096;
__device__ __forceinline__ bf16x8 rowfrag(const LAS unsigned char* tile, int row, int s, int g) { return *(const LAS bf16x8*)(tile + row * TP + (32 * s + 8 * g) * 2); }
__device__ __forceinline__ bf16x8 permfrag(const LAS unsigned char* tile, int row, int s, int g) {
    const s16x4 lo = *(const LAS s16x4*)(tile + row * TP + (32 * s + 4 * g) * 2), hi = *(const LAS s16x4*)(tile + row * TP + (32 * s + 16 + 4 * g) * 2); return PK8(lo, hi);
}
__device__ __forceinline__ bf16x8 trfrag(const LAS unsigned char* tile, int s, int col0, int g, int q, int p) {
    const LAS unsigned char* a = tile + (32 * s + 8 * g + q) * TP + (col0 + 4 * p) * 2;
    const s16x4 lo = trread(a), hi = trread(a + 4 * TP); return PK8(lo, hi);
}
__device__ __forceinline__ unsigned short f2bf1(float f) { return (unsigned short)(cvtpk(f, 0.f) & 0xffffu); }
__device__ __forceinline__ bf16x8 pack8(const f32x4& a, const f32x4& b) { u32x4 o; o.x = cvtpk(a[0], a[1]); o.y = cvtpk(a[2], a[3]); o.z = cvtpk(b[0], b[1]); o.w = cvtpk(b[2], b[3]); return __builtin_bit_cast(bf16x8, o); }
__device__ __forceinline__ bf16x8 pack4z(const f32x4& a) { u32x4 o; o.x = cvtpk(a[0], a[1]); o.y = cvtpk(a[2], a[3]); o.z = 0u; o.w = 0u; return __builtin_bit_cast(bf16x8, o); }

__device__ __forceinline__ void rwkv_chunk_unit(Frame& F, int bunit) {
    const int hg = bunit & 1, n = (bunit >> 1) & 63, b = bunit >> 7;
    const bf16_t* Z = (const bf16_t*)(F.ws + WS_Z); const float* mu = IN_F(10);
    const bf16_t* lt = (const bf16_t*)(F.ws + WS_LORA);
    const size_t row0 = (size_t)b * SEQ + (size_t)n * 64;
    const int w = F.wave, lane = F.lane, li = lane & 15, g = lane >> 4, q = li >> 2, p = li & 3;
    LAS unsigned char* lds = F.lds;
    bf16x8 af[3];
    {
        const int mat = w >> 2, tt = w & 3;
        const size_t row = row0 + 16 * tt + li; const bool hp = (n * 64 + 16 * tt + li) > 0;
#pragma unroll
        for (int ks = 0; ks < 3; ++ks) af[ks] = mat == 0 ? shift_frag<1>(Z, row, hp, ZO_ZW + 32 * ks + 8 * g, mu) : shift_frag<0>(Z, row, hp, ZO_ZA + 32 * ks + 8 * g, mu);
    }
    {
        const int t = F.tid >> 3, c0 = hg * 128 + (F.tid & 7) * 16;
        const size_t row = row0 + t; const bool hp = (n * 64 + t) > 0;
        bf16_t* sg = (bf16_t*)(F.ws + WS_SG) + row * 256 + c0;
        *(bf16x8*)sg = shift_frag<2>(Z, row, hp, ZO_ZG + c0, mu);
        *(bf16x8*)(sg + 8) = shift_frag<2>(Z, row, hp, ZO_ZG + c0 + 8, mu);
    }
#define RW_S0(h_) do { const int mat_ = w >> 2, tt_ = w & 3; const bf16_t* wt_ = lt + (size_t)mat_ * 1024 * 96; LAS float* pre_ = (LAS float*)(lds + (mat_ == 0 ? F_PD : F_PI)); \
        _Pragma("unroll") for (int ct_ = 0; ct_ < 4; ++ct_) { f32x4 acc_ = {0.f, 0.f, 0.f, 0.f}; \
            _Pragma("unroll") for (int ks_ = 0; ks_ < 3; ++ks_) { const bf16x8 bfr_ = *(const bf16x8*)(wt_ + (size_t)((h_) * 64 + 16 * ct_ + li) * 96 + 32 * ks_ + 8 * g); \
                acc_ = __builtin_amdgcn_mfma_f32_16x16x32_bf16(af[ks_], bfr_, acc_, 0, 0, 0); } \
            _Pragma("unroll") for (int i_ = 0; i_ < 4; ++i_) pre_[(16 * tt_ + 4 * g + i_) * 64 + 16 * ct_ + li] = acc_[i_]; } } while (0)
#define RW_ZLOAD(h_) do { const bf16_t* zb_ = Z + (row0 + 8 * w) * ZC + (h_) * 64 + lane; const bool hp_ = (n * 64 + 8 * w) > 0; \
        zr[0] = hp_ ? *(zb_ - ZC + ZO_R) : (bf16_t)0; zk[0] = hp_ ? *(zb_ - ZC + ZO_KW) : (bf16_t)0; zv[0] = hp_ ? *(zb_ - ZC + ZO_VW) : (bf16_t)0; \
        _Pragma("unroll") for (int j_ = 0; j_ < 8; ++j_) { zr[j_ + 1] = zb_[(size_t)j_ * ZC + ZO_R]; zk[j_ + 1] = zb_[(size_t)j_ * ZC + ZO_KW]; zv[j_ + 1] = zb_[(size_t)j_ * ZC + ZO_VW]; } } while (0)
    {
        for (int e = F.tid; e < 4 * 6 * 256; e += NTHR) {
            const int mt = e >> 8, el = e & 255, m = mt / 6, k6 = mt % 6, tt = (k6 >= 5) ? 2 : (k6 >= 3) ? 1 : 0, ct = (k6 >= 5) ? 3 : (k6 >= 3) ? (k6 - 3 + 2) : (k6 + 1);
            *(LAS unsigned short*)(lds + (m == 0 ? T_AAB : m == 1 ? T_AAK : m == 2 ? T_RB : T_RK) + (16 * tt + (el >> 4)) * TP + (16 * ct + (el & 15)) * 2) = 0;
        }
    }
    bf16_t zr[9], zk[9], zv[9];
    RW_ZLOAD(hg * 8);
    RW_S0(hg * 8);
    for (int hh = 0; hh < 8; ++hh) {
    const int h = hg * 8 + hh, unit = (b * 16 + h) * 64 + n;
    __syncthreads();
    float aj[8], bj[8], kmj[8], rj[8], vj[8], lwj[8], Lj[8];
    {
        const int c = lane, hc = h * 64 + c;
        const float w0 = IN_F(11)[hc], a0 = IN_F(13)[hc], k_k = IN_F(16)[hc], k_a = IN_F(17)[hc], r_k = IN_F(18)[hc];
        const float mur = mu[hc], muk = mu[1024 + hc], muv = mu[2048 + hc];
        const LAS float* PD = (const LAS float*)(lds + F_PD); const LAS float* PI = (const LAS float*)(lds + F_PI);
        float pr = bf2f(zr[0]), pk = bf2f(zk[0]), pvv = bf2f(zv[0]);
        float bonv[8], run = 0.f;
#pragma unroll
        for (int j = 0; j < 8; ++j) {
            const float cr = bf2f(zr[j + 1]), ck = bf2f(zk[j + 1]), cv = bf2f(zv[j + 1]);
            const float r = cr + (pr - cr) * mur, kw = ck + (pk - ck) * muk, vw = cv + (pvv - cv) * muv;
            pr = cr; pk = ck; pvv = cv;
            const float y = -(w0 + PD[(8 * w + j) * 64 + c]);
            const float sp = fmaxf(y, 0.f) + __logf(1.0f + __expf(-fabsf(y)));
            const float lw = -__expf(-sp - 0.5f);
            const float icl = sigmoidf_(a0 + PI[(8 * w + j) * 64 + c]);
            const float kkr = kw * k_k;
            const float inv = __builtin_amdgcn_rsqf(fmaxf(wave_sum(kkr * kkr), 1e-24f));
            const float kk = kkr * inv, km = kw * (1.0f + (icl - 1.0f) * k_a);
            bonv[j] = wave_sum(r * km * r_k);
            aj[j] = -kk; bj[j] = kk * icl; kmj[j] = km; rj[j] = r; vj[j] = vw; lwj[j] = lw; run += lw; Lj[j] = run;
        }
        ((LAS float*)(lds + F_SEG))[w * 64 + c] = run;
        if (lane < 8) { float bsel = bonv[0];
#pragma unroll
            for (int j = 1; j < 8; ++j) bsel = (lane == j) ? bonv[j] : bsel;
            ((float*)(F.ws + WS_BON))[(size_t)unit * 64 + 8 * w + lane] = bsel; }
    }
    __syncthreads();
    {
        const int c = lane; const LAS float* SEG = (const LAS float*)(lds + F_SEG);
        float off = 0.f, tot = 0.f;
#pragma unroll
        for (int ww = 0; ww < 8; ++ww) { const float sgv = SEG[ww * 64 + c]; tot += sgv; off += (ww < w) ? sgv : 0.f; }
        if (w == 0) { const float p63 = __expf(tot); ((LAS float*)(lds + F_P63))[c] = p63; ((float*)(F.ws + WS_P63))[(size_t)unit * 64 + c] = p63; }
#pragma unroll
        for (int j = 0; j < 8; ++j) {
            const float L = off + Lj[j], e1 = __expf(L - lwj[j]), e2 = __expf(-L), e3 = __builtin_amdgcn_rcpf(e2);
            const int to = (8 * w + j) * TP + c * 2;
            *(LAS unsigned short*)(lds + T_AT + to) = f2bf1(aj[j] * e1);
            *(LAS unsigned short*)(lds + T_BT + to) = f2bf1(bj[j] * e2);
            *(LAS unsigned short*)(lds + T_KT + to) = f2bf1(kmj[j] * e2);
            *(LAS unsigned short*)(lds + T_RT + to) = f2bf1(rj[j] * e3);
            *(LAS unsigned short*)(lds + T_VV + to) = f2bf1(vj[j]);
        }
    }
    if (hh < 7) { RW_ZLOAD(h + 1); RW_S0(h + 1); }
    __syncthreads();
    if (w == 0) {
#pragma unroll
        for (int tt = 0; tt < 4; ++tt) {
            f32x4 acc = {0.f, 0.f, 0.f, 0.f};
            acc = __builtin_amdgcn_mfma_f32_16x16x32_bf16(rowfrag(lds + T_AT, 16 * tt + li, 0, g), rowfrag(lds + T_BT, 16 * tt + li, 0, g), acc, 0, 0, 0);
            acc = __builtin_amdgcn_mfma_f32_16x16x32_bf16(rowfrag(lds + T_AT, 16 * tt + li, 1, g), rowfrag(lds + T_BT, 16 * tt + li, 1, g), acc, 0, 0, 0);
#pragma unroll
            for (int e = 0; e < 4; ++e) {
                const float v = (li < 4 * g + e) ? acc[e] : 0.f;
                ((LAS float*)(lds + F_DIAG))[(tt * 16 + 4 * g + e) * 16 + li] = v;
                *(LAS unsigned short*)(lds + T_AAB + (16 * tt + 4 * g + e) * TP + (16 * tt + li) * 2) = f2bf1(v);
            }
        }
        asm volatile("s_waitcnt lgkmcnt(0)" ::: "memory");
        const int bb = lane >> 4, jc = li; const LAS float* DG = (const LAS float*)(lds + F_DIAG) + bb * 256;
        float Tr[16];
#pragma unroll
        for (int r = 0; r < 16; ++r) {
            float acc0 = (r == jc) ? 1.f : 0.f, acc1 = 0.f;
#pragma unroll
            for (int i = 0; i < r; ++i) { if (i & 1) acc1 += DG[r * 16 + i] * Tr[i]; else acc0 += DG[r * 16 + i] * Tr[i]; }
            Tr[r] = acc0 + acc1;
        }
#pragma unroll
        for (int r = 0; r < 16; ++r) *(LAS unsigned short*)(lds + F_DT + ((bb * 16 + r) * 16 + jc) * 2) = f2bf1(Tr[r]);
    } else {
        for (int job = w - 1; job < 36; job += 7) {
            int m, tt, ct;
            if (job < 6) { m = 0; tt = (job >= 3) ? 3 : (job >= 1) ? 2 : 1; ct = job - ((tt - 1) * tt) / 2; }
            else { const int idx = job - 6, r = idx % 10; m = 1 + idx / 10; tt = (r >= 6) ? 3 : (r >= 3) ? 2 : (r >= 1) ? 1 : 0; ct = r - (tt * (tt + 1)) / 2; }
            const LAS unsigned char* srcA = lds + ((m < 2) ? T_AT : T_RT); const LAS unsigned char* srcB = lds + ((m & 1) ? T_KT : T_BT);
            LAS unsigned char* dst = lds + (m == 0 ? T_AAB : m == 1 ? T_AAK : m == 2 ? T_RB : T_RK);
            f32x4 acc = {0.f, 0.f, 0.f, 0.f};
            acc = __builtin_amdgcn_mfma_f32_16x16x32_bf16(rowfrag(srcA, 16 * tt + li, 0, g), rowfrag(srcB, 16 * ct + li, 0, g), acc, 0, 0, 0);
            acc = __builtin_amdgcn_mfma_f32_16x16x32_bf16(rowfrag(srcA, 16 * tt + li, 1, g), rowfrag(srcB, 16 * ct + li, 1, g), acc, 0, 0, 0);
            if (ct == tt) {
#pragma unroll
                for (int e = 0; e < 4; ++e) { const bool keep = (m >= 2) ? (li <= 4 * g + e) : (li < 4 * g + e); acc[e] = keep ? acc[e] : 0.f; }
            }
#pragma unroll
            for (int e = 0; e < 4; ++e) *(LAS unsigned short*)(dst + (16 * tt + 4 * g + e) * TP + (16 * ct + li) * 2) = f2bf1(acc[e]);
        }
    }
    __syncthreads();
    f32x4 av[4];
#pragma unroll
    for (int i = 0; i < 4; ++i) av[i] = (f32x4){0.f, 0.f, 0.f, 0.f};
    if (w >= 4) {
        const int ct = w - 4;
        const bf16x8 v0 = trfrag(lds + T_VV, 0, 16 * ct, g, q, p), v1 = trfrag(lds + T_VV, 1, 16 * ct, g, q, p);
#pragma unroll
        for (int tt = 0; tt < 4; ++tt) {
            av[tt] = __builtin_amdgcn_mfma_f32_16x16x32_bf16(rowfrag(lds + T_AAK, 16 * tt + li, 0, g), v0, av[tt], 0, 0, 0);
            av[tt] = __builtin_amdgcn_mfma_f32_16x16x32_bf16(rowfrag(lds + T_AAK, 16 * tt + li, 1, g), v1, av[tt], 0, 0, 0);
        }
    }
    {
        const int cs = w & 3; const bool isU = w >= 4;
        f32x4 X[4];
#pragma unroll
        for (int bb = 0; bb < 4; ++bb) {
            f32x4 acc;
            if (isU) acc = av[bb];
            else {
#pragma unroll
                for (int e = 0; e < 4; ++e) acc[e] = bf2f(*(const LAS unsigned short*)(lds + T_AT + (16 * bb + 4 * g + e) * TP + (16 * cs + li) * 2));
            }
            if (bb >= 1) {
                const f32x4 zz = {0.f, 0.f, 0.f, 0.f};
                acc = __builtin_amdgcn_mfma_f32_16x16x32_bf16(permfrag(lds + T_AAB, 16 * bb + li, 0, g), pack8(X[0], bb >= 2 ? X[1] : zz), acc, 0, 0, 0);
            }
            if (bb == 3) acc = __builtin_amdgcn_mfma_f32_16x16x32_bf16(permfrag(lds + T_AAB, 16 * bb + li, 1, g), pack4z(X[2]), acc, 0, 0, 0);
            const s16x4 dlo = *(const LAS s16x4*)(lds + F_DT + ((bb * 16 + li) * 16 + 4 * g) * 2);
            const bf16x8 ad = (bf16x8){dlo[0], dlo[1], dlo[2], dlo[3], 0, 0, 0, 0};
            X[bb] = __builtin_amdgcn_mfma_f32_16x16x32_bf16(ad, pack4z(acc), (f32x4){0.f, 0.f, 0.f, 0.f}, 0, 0, 0);
        }
        LAS unsigned char* dst = lds + (isU ? T_U0 : T_WW);
#pragma unroll
        for (int bb = 0; bb < 4; ++bb)
#pragma unroll
            for (int e = 0; e < 4; ++e) *(LAS unsigned short*)(dst + (16 * bb + 4 * g + e) * TP + (16 * cs + li) * 2) = f2bf1(X[bb][e]);
    }
    __syncthreads();
    {
        const int ct = w & 3;
        unsigned char* co = (unsigned char*)F.out;
        if (w < 4) {
            {
                const bf16x8 b0 = trfrag(lds + T_BT, 0, 16 * ct, g, q, p), b1 = trfrag(lds + T_BT, 1, 16 * ct, g, q, p);
                const float pc = ((const LAS float*)(lds + F_P63))[16 * ct + li];
                f32x4 acc[4];
#pragma unroll
                for (int tt = 0; tt < 4; ++tt) {
                    acc[tt] = __builtin_amdgcn_mfma_f32_16x16x32_bf16(trfrag(lds + T_WW, 0, 16 * tt, g, q, p), b0, (f32x4){0.f, 0.f, 0.f, 0.f}, 0, 0, 0);
                    acc[tt] = __builtin_amdgcn_mfma_f32_16x16x32_bf16(trfrag(lds + T_WW, 1, 16 * tt, g, q, p), b1, acc[tt], 0, 0, 0);
                    acc[tt] *= pc;
                }
                bf16x8* o = (bf16x8*)(co + RWC_QTF + (size_t)unit * 8192) + (ct * 2) * 64 + lane;
                o[0] = pack8(acc[0], acc[1]); o[64] = pack8(acc[2], acc[3]);
            }
            {
                const bf16x8 u0 = trfrag(lds + T_U0, 0, 16 * ct, g, q, p), u1 = trfrag(lds + T_U0, 1, 16 * ct, g, q, p);
                const bf16x8 v0 = trfrag(lds + T_VV, 0, 16 * ct, g, q, p), v1 = trfrag(lds + T_VV, 1, 16 * ct, g, q, p);
                f32x4 acc[4];
#pragma unroll
                for (int tt = 0; tt < 4; ++tt) {
                    acc[tt] = __builtin_amdgcn_mfma_f32_16x16x32_bf16(trfrag(lds + T_BT, 0, 16 * tt, g, q, p), u0, (f32x4){0.f, 0.f, 0.f, 0.f}, 0, 0, 0);
                    acc[tt] = __builtin_amdgcn_mfma_f32_16x16x32_bf16(trfrag(lds + T_BT, 1, 16 * tt, g, q, p), u1, acc[tt], 0, 0, 0);
                    acc[tt] = __builtin_amdgcn_mfma_f32_16x16x32_bf16(trfrag(lds + T_KT, 0, 16 * tt, g, q, p), v0, acc[tt], 0, 0, 0);
                    acc[tt] = __builtin_amdgcn_mfma_f32_16x16x32_bf16(trfrag(lds + T_KT, 1, 16 * tt, g, q, p), v1, acc[tt], 0, 0, 0);
                    acc[tt] *= *(const LAS f32x4*)(lds + F_P63 + (16 * tt + 4 * g) * 4);
                }
                bf16x8* o = (bf16x8*)(co + RWC_NTF + (size_t)unit * 8192) + (ct * 64 + lane) * 2;
                o[0] = pack8(acc[0], acc[1]); o[1] = pack8(acc[2], acc[3]);
            }
        } else {
            const bf16x8 rb0 = rowfrag(lds + T_RB, 16 * ct + li, 0, g), rb1 = rowfrag(lds + T_RB, 16 * ct + li, 1, g);
            {
                f32x4 acc[4];
#pragma unroll
                for (int tt = 0; tt < 4; ++tt) {
                    const s16x4 r4 = *(const LAS s16x4*)(lds + T_RT + (16 * ct + li) * TP + (16 * tt + 4 * g) * 2);
#pragma unroll
                    for (int e = 0; e < 4; ++e) acc[tt][e] = bf2f((unsigned short)r4[e]);
                    acc[tt] = __builtin_amdgcn_mfma_f32_16x16x32_bf16(trfrag(lds + T_WW, 0, 16 * tt, g, q, p), rb0, acc[tt], 0, 0, 0);
                    acc[tt] = __builtin_amdgcn_mfma_f32_16x16x32_bf16(trfrag(lds + T_WW, 1, 16 * tt, g, q, p), rb1, acc[tt], 0, 0, 0);
                }
                bf16x8* o = (bf16x8*)(co + RWC_RWF + (size_t)unit * 8192) + (ct * 2) * 64 + lane;
                o[0] = pack8(acc[0], acc[1]); o[64] = pack8(acc[2], acc[3]);
            }
            {
                const bf16x8 rk0 = rowfrag(lds + T_RK, 16 * ct + li, 0, g), rk1 = rowfrag(lds + T_RK, 16 * ct + li, 1, g);
                f32x4 acc[4];
#pragma unroll
                for (int tt = 0; tt < 4; ++tt) {
                    acc[tt] = __builtin_amdgcn_mfma_f32_16x16x32_bf16(trfrag(lds + T_U0, 0, 16 * tt, g, q, p), rb0, (f32x4){0.f, 0.f, 0.f, 0.f}, 0, 0, 0);
                    acc[tt] = __builtin_amdgcn_mfma_f32_16x16x32_bf16(trfrag(lds + T_U0, 1, 16 * tt, g, q, p), rb1, acc[tt], 0, 0, 0);
                    acc[tt] = __builtin_amdgcn_mfma_f32_16x16x32_bf16(trfrag(lds + T_VV, 0, 16 * tt, g, q, p), rk0, acc[tt], 0, 0, 0);
                    acc[tt] = __builtin_amdgcn_mfma_f32_16x16x32_bf16(trfrag(lds + T_VV, 1, 16 * tt, g, q, p), rk1, acc[tt], 0, 0, 0);
                }
                bf16x8* o = (bf16x8*)(co + RWC_Y0F + (size_t)unit * 8192) + (ct * 64 + lane) * 2;
                o[0] = pack8(acc[0], acc[1]); o[1] = pack8(acc[2], acc[3]);
            }
        }
    }
    }
#undef RW_S0
#undef RW_ZLOAD
}
constexpr int SC_D = 8, SC_SLOT = 16896;
struct ScanRegs { bf16x8 qa[4][2]; f32x4 pv[4]; u32x4 n0, n1; };
__device__ __forceinline__ void scan_fetch(ScanRegs& r, const LAS unsigned char* sl, int vs, int lane, int g) {
#pragma unroll
    for (int kt = 0; kt < 4; ++kt) { r.qa[kt][0] = *(const LAS bf16x8*)(sl + (kt * 2) * 1024 + lane * 16); r.qa[kt][1] = *(const LAS bf16x8*)(sl + (kt * 2 + 1) * 1024 + lane * 16); r.pv[kt] = *(const LAS f32x4*)(sl + 16384 + (16 * kt + 4 * g) * 4); }
    r.n0 = *(const LAS u32x4*)(sl + 8192 + (vs * 2) * 1024 + lane * 16); r.n1 = *(const LAS u32x4*)(sl + 8192 + (vs * 2 + 1) * 1024 + lane * 16);
}
__device__ __forceinline__ void scan_compute(f32x4 (&X)[4], const ScanRegs& r, unsigned char* ws, size_t unit, int vs, int lane) {
    const bf16x8 xb0 = pack8(X[0], X[1]), xb1 = pack8(X[2], X[3]);
    bf16x8* xo = (bf16x8*)(ws + WS_XF + unit * 8192) + (vs * 2) * 64 + lane;
    xo[0] = xb0; xo[64] = xb1;
    const unsigned nw[8] = {r.n0.x, r.n0.y, r.n0.z, r.n0.w, r.n1.x, r.n1.y, r.n1.z, r.n1.w};
#pragma unroll
    for (int kt = 0; kt < 4; ++kt) {
        f32x4 acc; acc[0] = r.pv[kt][0] * X[kt][0] + bflo(nw[2 * kt]); acc[1] = r.pv[kt][1] * X[kt][1] + bfhi(nw[2 * kt]); acc[2] = r.pv[kt][2] * X[kt][2] + bflo(nw[2 * kt + 1]); acc[3] = r.pv[kt][3] * X[kt][3] + bfhi(nw[2 * kt + 1]);
        acc = __builtin_amdgcn_mfma_f32_16x16x32_bf16(r.qa[kt][0], xb0, acc, 0, 0, 0);
        acc = __builtin_amdgcn_mfma_f32_16x16x32_bf16(r.qa[kt][1], xb1, acc, 0, 0, 0);
        X[kt] = acc;
    }
}
__device__ __forceinline__ void rwkv_scan_block(Frame& F, int bh, int hv) {
    const int lane = F.lane, g = lane >> 4, w = F.wave;
    LAS unsigned char* lds = F.lds;
    const unsigned char* co = (const unsigned char*)F.out;
    const size_t u0 = (size_t)bh * 64;
    if (w >= 4) {
        const int j = w - 4;
        u32x4 bq0[SC_D], bq1[SC_D], bn0[SC_D]; float bp[SC_D];
        const int nt_dst = 8192 + ((2 * hv + (j >> 1)) * 2 + (lane & 1)) * 1024 + ((j & 1) * 32 + (lane >> 1)) * 16;
#define SC_LOAD(m_, i_) do { const size_t un_ = u0 + (m_); \
            const u32x4* q_ = (const u32x4*)(co + RWC_QTF + un_ * 8192) + lane; const u32x4* n_ = (const u32x4*)(co + RWC_NTF + un_ * 8192) + hv * 256 + j * 64 + lane; \
            bq0[i_] = q_[(2 * j) * 64]; bq1[i_] = q_[(2 * j + 1) * 64]; bn0[i_] = n_[0]; \
            bp[i_] = ((const float*)(F.ws + WS_P63))[un_ * 64 + lane]; } while (0)
#pragma unroll
        for (int i = 0; i < SC_D; ++i) SC_LOAD(i, i);
        for (int n0 = 0; n0 < 64; n0 += SC_D) {
#pragma unroll
            for (int i = 0; i < SC_D; ++i) {
                const int n = n0 + i;
                LAS unsigned char* sl = lds + (n % 3) * SC_SLOT;
                *(LAS u32x4*)(sl + (2 * j) * 1024 + lane * 16) = bq0[i]; *(LAS u32x4*)(sl + (2 * j + 1) * 1024 + lane * 16) = bq1[i];
                *(LAS u32x4*)(sl + nt_dst) = bn0[i];
                *(LAS float*)(sl + 16384 + lane * 4) = bp[i];
                { const int m_ = (n + SC_D < 64) ? n + SC_D : 63; SC_LOAD(m_, i); }
                asm volatile("s_waitcnt lgkmcnt(0)" ::: "memory");
                __builtin_amdgcn_s_barrier();
            }
        }
#undef SC_LOAD
        __builtin_amdgcn_s_barrier();
    } else if (w < 2) {
        const int vs = 2 * hv + w;
        f32x4 X[4];
#pragma unroll
        for (int i = 0; i < 4; ++i) X[i] = (f32x4){0.f, 0.f, 0.f, 0.f};
        ScanRegs ra, rb;
        __builtin_amdgcn_s_barrier(); asm volatile("" ::: "memory");
        scan_fetch(ra, lds + 0 * SC_SLOT, vs, lane, g);
        for (int n = 0; n < 64; n += 2) {
            asm volatile("s_waitcnt lgkmcnt(0)" ::: "memory");
            __builtin_amdgcn_s_barrier(); asm volatile("" ::: "memory"); __builtin_amdgcn_sched_barrier(0);
            scan_fetch(rb, lds + ((n + 1) % 3) * SC_SLOT, vs, lane, g);
            __builtin_amdgcn_sched_barrier(0);
            scan_compute(X, ra, F.ws, u0 + n, vs, lane);
            __builtin_amdgcn_sched_barrier(0);
            asm volatile("s_waitcnt lgkmcnt(0)" ::: "memory");
            __builtin_amdgcn_s_barrier(); asm volatile("" ::: "memory"); __builtin_amdgcn_sched_barrier(0);
            if (n + 2 < 64) scan_fetch(ra, lds + ((n + 2) % 3) * SC_SLOT, vs, lane, g);
            __builtin_amdgcn_sched_barrier(0);
            scan_compute(X, rb, F.ws, u0 + n + 1, vs, lane);
            __builtin_amdgcn_sched_barrier(0);
        }
    } else {
        for (int n = 0; n < 65; ++n) __builtin_amdgcn_s_barrier();
    }
    __syncthreads();
}
constexpr int RO_PITCH = 136, RO_ZT = 0, RO_GT = 65 * RO_PITCH, RO_WAVE = 17600;
__device__ __forceinline__ void rwkv_out_wave(Frame& F, int unit) {
    const int n = unit & 63, bh = unit >> 6, h = bh & 15, b = bh >> 4;
    const int lane = F.lane, li = lane & 15, g = lane >> 4;
    const bf16_t* Z = (const bf16_t*)(F.ws + WS_Z); const float* mu = IN_F(10);
    const unsigned char* co = (const unsigned char*)F.out;
    LAS unsigned char* wl = F.lds + F.wave * RO_WAVE;
    const size_t row0 = (size_t)b * SEQ + (size_t)n * 64;
    bf16_t* Yh = (bf16_t*)(F.ws + WS_Y) + 1024 + h * 64;
    const int rr = lane >> 3, ch = lane & 7;
    u32x4 zst[9], gst[8];
#pragma unroll
    for (int i = 0; i < 9; ++i) {
        const int r = 8 * i + rr;
        zst[i] = (u32x4){0u, 0u, 0u, 0u};
        if (r <= 64 && (r > 0 || n > 0)) zst[i] = *(const u32x4*)(Z + (row0 - 1 + r) * ZC + ZO_VW + h * 64 + ch * 8);
    }
#pragma unroll
    for (int i = 0; i < 8; ++i) gst[i] = *(const u32x4*)(Yh + (row0 + 8 * i + rr) * 2048 + ch * 8);
    const bf16x8* xf = (const bf16x8*)(F.ws + WS_XF + (size_t)unit * 8192) + lane;
    bf16x8 xa[4][2], rf[4][2], yf[4][2]; float bon[4];
#pragma unroll
    for (int vt = 0; vt < 4; ++vt) { xa[vt][0] = xf[(vt * 2) * 64]; xa[vt][1] = xf[(vt * 2 + 1) * 64]; }
#pragma unroll
    for (int tt = 0; tt < 4; ++tt) {
        const bf16x8* rp = (const bf16x8*)(co + RWC_RWF + (size_t)unit * 8192) + (tt * 2) * 64 + lane;
        rf[tt][0] = rp[0]; rf[tt][1] = rp[64];
        const bf16x8* yp = (const bf16x8*)(co + RWC_Y0F + (size_t)unit * 8192) + (tt * 64 + lane) * 2;
        yf[tt][0] = yp[0]; yf[tt][1] = yp[1];
        bon[tt] = ((const float*)(F.ws + WS_BON))[(size_t)unit * 64 + 16 * tt + li];
    }
#pragma unroll
    for (int i = 0; i < 9; ++i) { const int r = 8 * i + rr; if (r <= 64) { LAS u32x2* d = (LAS u32x2*)(wl + RO_ZT + r * RO_PITCH + ch * 16); d[0] = (u32x2){zst[i].x, zst[i].y}; d[1] = (u32x2){zst[i].z, zst[i].w}; } }
#pragma unroll
    for (int i = 0; i < 8; ++i) { LAS u32x2* d = (LAS u32x2*)(wl + RO_GT + (8 * i + rr) * RO_PITCH + ch * 16); d[0] = (u32x2){gst[i].x, gst[i].y}; d[1] = (u32x2){gst[i].z, gst[i].w}; }
    asm volatile("s_waitcnt lgkmcnt(0)" ::: "memory");
    const float* lnw = IN_F(19) + h * 64; const float* lnb = IN_F(20) + h * 64;
#pragma unroll
    for (int tt = 0; tt < 4; ++tt) {
        const u32x4 y0 = __builtin_bit_cast(u32x4, yf[tt][0]), y1 = __builtin_bit_cast(u32x4, yf[tt][1]);
        const unsigned yw[8] = {y0.x, y0.y, y0.z, y0.w, y1.x, y1.y, y1.z, y1.w};
        f32x4 ya[4];
#pragma unroll
        for (int vt = 0; vt < 4; ++vt) {
            f32x4 acc; acc[0] = bflo(yw[2 * vt]); acc[1] = bfhi(yw[2 * vt]); acc[2] = bflo(yw[2 * vt + 1]); acc[3] = bfhi(yw[2 * vt + 1]);
            acc = __builtin_amdgcn_mfma_f32_16x16x32_bf16(xa[vt][0], rf[tt][0], acc, 0, 0, 0);
            ya[vt] = __builtin_amdgcn_mfma_f32_16x16x32_bf16(xa[vt][1], rf[tt][1], acc, 0, 0, 0);
        }
        float s = 0.f;
#pragma unroll
        for (int vt = 0; vt < 4; ++vt) s += (ya[vt][0] + ya[vt][1]) + (ya[vt][2] + ya[vt][3]);
        s += __shfl_xor(s, 16); s += __shfl_xor(s, 32);
        const float mean = s * (1.0f / 64.0f); float qv = 0.f;
#pragma unroll
        for (int vt = 0; vt < 4; ++vt) { const f32x4 d = ya[vt] - mean; qv += (d[0] * d[0] + d[1] * d[1]) + (d[2] * d[2] + d[3] * d[3]); }
        qv += __shfl_xor(qv, 16); qv += __shfl_xor(qv, 32);
        const float rstd = rsqrtf(qv * (1.0f / 64.0f) + 64e-5f);
        const int tr = 16 * tt + li;
#pragma unroll
        for (int vt = 0; vt < 4; ++vt) {
            const int vc = 16 * vt + 4 * g;
            const f32x4 m4 = *(const f32x4*)(mu + 2048 + h * 64 + vc), w4 = *(const f32x4*)(lnw + vc), b4 = *(const f32x4*)(lnb + vc);
            const u32x2 c_ = *(const LAS u32x2*)(wl + RO_ZT + (tr + 1) * RO_PITCH + vc * 2), p_ = *(const LAS u32x2*)(wl + RO_ZT + tr * RO_PITCH + vc * 2);
            LAS u32x2* gp = (LAS u32x2*)(wl + RO_GT + tr * RO_PITCH + vc * 2);
            const u32x2 g_ = *gp;
            f32x4 vw; { const float c0 = bflo(c_.x), c1 = bfhi(c_.x), c2 = bflo(c_.y), c3 = bfhi(c_.y);
                vw[0] = c0 + (bflo(p_.x) - c0) * m4[0]; vw[1] = c1 + (bfhi(p_.x) - c1) * m4[1]; vw[2] = c2 + (bflo(p_.y) - c2) * m4[2]; vw[3] = c3 + (bfhi(p_.y) - c3) * m4[3]; }
            const f32x4 gv = {bflo(g_.x), bfhi(g_.x), bflo(g_.y), bfhi(g_.y)};
            const f32x4 o = (((ya[vt] - mean) * rstd) * w4 + b4 + vw * bon[tt]) * gv;
            u32x2 wv; wv.x = cvtpk(o[0], o[1]); wv.y = cvtpk(o[2], o[3]);
            *gp = wv;
        }
    }
    asm volatile("s_waitcnt lgkmcnt(0)" ::: "memory");
#pragma unroll
    for (int i = 0; i < 8; ++i) {
        const LAS u32x2* sp = (const LAS u32x2*)(wl + RO_GT + (8 * i + rr) * RO_PITCH + ch * 16);
        const u32x2 lo = sp[0], hi = sp[1];
        *(u32x4*)(Yh + (row0 + 8 * i + rr) * 2048 + ch * 8) = (u32x4){lo.x, lo.y, hi.x, hi.y};
    }
}

struct Args { const float* in[26]; float* out; unsigned char* ws; int ph_lo, ph_hi, li, pad; };
constexpr int N_PHASES = 12;
#ifndef MK_ONE_LAUNCH
#define MK_ONE_LAUNCH 1
#endif

__global__ void __launch_bounds__(NTHR, 2) fwd_kernel(Args args) {
    extern __shared__ __attribute__((aligned(16))) unsigned char lds_raw[];
    Frame F;
    F.lds = (LAS unsigned char*)lds_raw;
    F.MISC = (volatile LAS unsigned*)(F.lds + MISC_OFF);
    F.tid = threadIdx.x; F.lane = F.tid & 63; F.wave = __builtin_amdgcn_readfirstlane(F.tid >> 6);
    F.G = gridDim.x; { const int bx = blockIdx.x; F.vcu = (F.G % 8 == 0) ? (bx % 8) * (F.G / 8) + bx / 8 : bx; }
    F.in = args.in; F.out = args.out; F.ws = args.ws; F.ctl = (unsigned*)(args.ws + WS_CTL);
    for (int u = F.tid; u < (LDS_BYTES - LDSCTL_OFF) / 4; u += NTHR) ((LAS unsigned*)(F.lds + LDSCTL_OFF))[u] = 0u;
    __syncthreads();
    XcdBarrier bar; bar.bar = F.ctl + CW_BAR; bar.x = 0; bar.st = nullptr;
    if (MK_ONE_LAUNCH) bar = xcd_barrier_post(F.ctl + CW_BAR, F.MISC + 8);
    const int lo = args.ph_lo, hi = args.ph_hi;
#ifndef PHMASK
#define PHMASK 0xFFF
#endif
#define IN(k) (((PHMASK >> (k)) & 1) && lo <= (k) && (k) < hi)
#ifndef DUPMASK
#define DUPMASK 0x0
#endif
#define REP(k) _Pragma("unroll") for (int rep_ = 0; rep_ < (((DUPMASK >> (k)) & 1) ? 2 : 1); ++rep_)
#define DUPN(k) (((DUPMASK >> (k)) & 1) ? 2 : 1)
#define SEAM(k) do { if (IN(k)) xcd_barrier(bar); } while (0)
    float* mod = (float*)(F.ctl + CW_MOD);
    bf16_t* U = (bf16_t*)(F.ws + WS_U); bf16_t* Zb = (bf16_t*)(F.ws + WS_Z); bf16_t* Yb = (bf16_t*)(F.ws + WS_Y);

    if (IN(0)) {
        p0_ada(F, 1.0f);
        if ((F.vcu & 31) >= 24) p0_small(F, (F.vcu >> 5) * 8 + (F.vcu & 31) - 24);
        { const int gw_ = F.vcu * NWAVES + F.wave, NGW_ = F.G * NWAVES; p0_transposes(F, TR_WIN_LO, TR_WIN_HI - TR_WIN_LO, gw_, NGW_); }
        p0_wait_ada(F, 48u * 4u);
        norm_mod_rows(F, IN_F(0), IN_F(5), 2048, 0, U);
    } SEAM(1);
    if (IN(2)) REP(2) {
        pg8::Gemm g{U, (const bf16_t*)(F.ws + WS_WIN), M, ZC, D, D, D, 0}; pg8::StaticOrder S; S.init(M, ZC, F.G, (int)blockIdx.x); S.zp = 1;
        pg8::EpiZ E{Zb, (const float*)(F.ws + WS_ROPE), (const float*)(F.ws + WS_ROPE) + (size_t)M * 128, IN_F(9)};
        pg8::gemm_phase<pg8::EpiZ, true, true>(F.lds, g, S, E);
        constexpr int NU_ = (M / 256) * (ZC / 256), TAIL0_ = NU_ % 256;
        if (TAIL0_ != 0 && (int)blockIdx.x >= TAIL0_) p0_transposes(F, TR_MO_LO, (TR_MO_HI - TR_MO_LO) + F1G, ((int)blockIdx.x - TAIL0_) * NWAVES + F.wave, (256 - TAIL0_) * NWAVES);
    } SEAM(2);
    if (IN(3)) { for (int u = F.vcu; u < 256 * DUPN(3); u += F.G) ret_kv_unit(F, u & 255); for (int u = F.vcu; u < 256 * DUPN(12); u += F.G) rwkv_chunk_unit(F, u & 255); } SEAM(3);
    if (IN(4)) {
        constexpr int F1C = 2560;
        const int xg = F.vcu >> 5, r = F.vcu & 31;
        if (r < 8) { rwkv_scan_block(F, xg * 4 + (r >> 1), r & 1); if (MK_ONE_LAUNCH) dep_signal(F.ctl + CW_DSCAN + 16 * (xg * 4 + (r >> 1)), nullptr); }
        else if (r < 24) {
            const int gi = xg * 16 + (r - 8);
            pg8::Gemm g{(const bf16_t*)(F.ws + WS_SG), (const bf16_t*)(F.ws + WS_LORA) + 2 * 1024 * 96, M, 1024, 256, 256, 256, 0};
            pg8::StaticOrder S; S.init(M, 1024, 128, gi);
            pg8::EpiPlain<2048, 1024> E{Yb}; pg8::gemm_phase<pg8::EpiPlain<2048, 1024>, false, true>(F.lds, g, S, E);
            ret_scan(F, 128, gi);
            if (MK_ONE_LAUNCH) { pg8::Unit u0; (void)S.next(0, u0); dep_signal(F.ctl + CW_DRET + 16 * (gi >> 4), F.ctl + CW_DGATE + 4 * (u0.pm * 4 + u0.pn)); }
            p0_transposes(F, TR_F1_LO + F1G + F1C, (TR_F1_HI - TR_F1_LO) - F1G - F1C, gi * NWAVES + F.wave, 128 * NWAVES);
        } else { const int ci = xg * 8 + (r - 24); p0_transposes(F, TR_F1_LO + F1G, F1C, ci * NWAVES + F.wave, 64 * NWAVES); }
    }
    if (IN(5)) {
        if (MK_ONE_LAUNCH) dep_wait3(F.ctl + CW_DRET + 16 * (F.vcu >> 5), 16u, nullptr, 0u, nullptr, 0u);
        ret_out_unit(F, F.vcu & 255);
        if (MK_ONE_LAUNCH) { const int bhw = F.vcu >> 3, pa = (bhw >> 4) * 16 + (F.vcu & 7) * 2, pn = (bhw & 15) >> 2;
            dep_wait3(F.ctl + CW_DSCAN + 16 * bhw, 2u, F.ctl + CW_DGATE + 4 * (pa * 4 + pn), 1u, F.ctl + CW_DGATE + 4 * ((pa + 1) * 4 + pn), 1u); }
        rwkv_out_wave(F, (F.vcu * NWAVES + F.wave) & 2047);
    } SEAM(5);
    if (IN(6)) REP(6) {
        pg8::StaticOrder S; S.init(M, D, F.G, (int)blockIdx.x);
        pg8::Gemm g{Yb, (const bf16_t*)(F.ws + WS_WMRG), M, D, D, D, D, 16};
        pg8::EpiMerge E{Zb, U}; pg8::gemm_phase<pg8::EpiMerge, false, true>(F.lds, g, S, E);
        if (MK_ONE_LAUNCH && IN(7)) { pg8::Unit u0; if (S.next(0, u0)) panel_barrier(F.ctl + CW_PANEL + 16 * u0.pm, 8u); }
    }
    if (IN(7)) {
        pg8::Gemm g{U, (const bf16_t*)(F.ws + WS_WO), M, D, D, D, D, 0}; pg8::StaticOrder S; S.init(M, D, F.G, (int)blockIdx.x);
        if (DUPN(7) == 2) { pg8::EpiNull E0; pg8::gemm_phase<pg8::EpiNull, false, true>(F.lds, g, S, E0); }
        pg8::EpiResNorm<0> E{IN_F(0), F.out, mod + 4096, IN_F(6), mod + 6144, U, (float*)(F.ws + WS_ROPE), F.ctl + CW_CNT};
        pg8::gemm_phase<pg8::EpiResNorm<0>, false, true>(F.lds, g, S, E);
    } SEAM(7);
    if (IN(9)) REP(9) {
        pg8::Gemm g{U, (const bf16_t*)(F.ws + WS_WF1), M, FF2, D, D, D, 0}; pg8::StaticOrder S; S.init(M, FF2, F.G, (int)blockIdx.x);
        pg8::EpiSwiglu E{Zb}; pg8::gemm_phase<pg8::EpiSwiglu, true, true>(F.lds, g, S, E);
        constexpr int NU_ = (M / 256) * (FF2 / 256), TAIL0_ = NU_ % 256;
        if (TAIL0_ != 0 && (int)blockIdx.x >= TAIL0_) p0_transposes(F, TR_F2_LO, TR_F2_HI - TR_F2_LO, ((int)blockIdx.x - TAIL0_) * NWAVES + F.wave, (256 - TAIL0_) * NWAVES);
    } SEAM(9);
    if (IN(10)) {
        pg8::Gemm g{Zb, (const bf16_t*)(F.ws + WS_WF2), M, D, FFH, FFH, FFH, 0}; pg8::StaticOrder S; S.init(M, D, F.G, (int)blockIdx.x);
        if (DUPN(10) == 2) { pg8::EpiNull E0; pg8::gemm_phase<pg8::EpiNull, false, true>(F.lds, g, S, E0); }
        pg8::EpiResNorm<1> E{F.out, F.out, mod + 10240, IN_F(7), mod, nullptr, (float*)(F.ws + WS_ROPE) + 8 * 8192, F.ctl + CW_CNT + 32 * 64};
        pg8::gemm_phase<pg8::EpiResNorm<1>, false, true>(F.lds, g, S, E);
    }
#undef IN
#undef SEAM
}

extern "C" void kernel_launch(void* const* d_in, const int* in_sizes, int n_in, void* d_out, int out_size, void* d_ws, size_t ws_size, hipStream_t stream) {
    static int grid = 0;
    if (grid == 0) {
        if (n_in != 26 || out_size != M * D || ws_size < WS_END) { fprintf(stderr, "kernel_launch: unexpected shapes n_in %d out %d ws %zu\n", n_in, out_size, ws_size); grid = -1; return; }
        int dev = 0, cus = 0, per_cu = 0;
        if (hipGetDevice(&dev) != hipSuccess || hipDeviceGetAttribute(&cus, hipDeviceAttributeMultiprocessorCount, dev) != hipSuccess) { grid = -1; return; }
        if (hipFuncSetAttribute((const void*)fwd_kernel, hipFuncAttributeMaxDynamicSharedMemorySize, LDS_BYTES) != hipSuccess) { fprintf(stderr, "kernel_launch: hipFuncSetAttribute failed\n"); grid = -1; return; }
        if (hipOccupancyMaxActiveBlocksPerMultiprocessor(&per_cu, (const void*)fwd_kernel, NTHR, LDS_BYTES) != hipSuccess || per_cu < 1) { fprintf(stderr, "kernel_launch: occupancy query says %d\n", per_cu); per_cu = 1; }
        (void)hipGetLastError();
        grid = cus;
    }
    if (grid < 0) return;
    (void)hipMemsetAsync((char*)d_ws + WS_CTL, 0, CTL_ZERO_BYTES, stream);
    Args a{};
    for (int i = 0; i < 26; ++i) a.in[i] = (const float*)d_in[i];
    a.out = (float*)d_out; a.ws = (unsigned char*)d_ws;
#if MK_ONE_LAUNCH
    a.ph_lo = 0; a.ph_hi = N_PHASES; a.li = 0;
    hipLaunchKernelGGL(fwd_kernel, dim3(grid), dim3(NTHR), LDS_BYTES, stream, a);
#else
    for (int p = 0; p < N_PHASES; ++p) { a.ph_lo = p; a.ph_hi = p + 1; a.li = p; hipLaunchKernelGGL(fwd_kernel, dim3(grid), dim3(NTHR), LDS_BYTES, stream, a); }
#endif
}
```
